# Optimizing an MI355X kernel written in HIP

```python
import jax
import jax.numpy as jnp
from jax import lax
import numpy as np


D_MODEL = 1024
BATCH = 8
SEQ = 4096
DEPTH = 4

GRID_W = 64
CTX_LEN = 256
HEAD_DIM = 64
ROPE_THETA = 10000.0
Q_BLOCK = 128
EPS = 1e-6

GLA_HEADS = 4
GLA_DK = 32
GLA_DV = 64
GLA_WIDTH = GLA_HEADS * GLA_DV
GLA_GATE_RANK = 16
GLA_GATE_NORM = 16.0
GLA_CHUNK = 64

MLA_HEADS = 6
MLA_NOPE = 64
MLA_ROPE = 32
MLA_V = 64
MLA_Q_LORA = 256
MLA_KV_LORA = 256
MLA_WIDTH = MLA_HEADS * MLA_V

GQA_HEADS = 6
GQA_KV_HEADS = 2
GQA_GROUP = GQA_HEADS // GQA_KV_HEADS
GQA_WIDTH = GQA_HEADS * HEAD_DIM

D_MIX = GLA_WIDTH + MLA_WIDTH + GQA_WIDTH
GLA_COLS = (GLA_HEADS * GLA_DK, GLA_HEADS * GLA_DK, GLA_WIDTH, GLA_WIDTH, 2 * GLA_GATE_RANK)
MLA_COLS = (MLA_Q_LORA, MLA_KV_LORA, MLA_ROPE, MLA_WIDTH)
GQA_COLS = (GQA_HEADS * HEAD_DIM, GQA_KV_HEADS * HEAD_DIM, GQA_KV_HEADS * HEAD_DIM, GQA_WIDTH)
IN_COLS = GLA_COLS + MLA_COLS + GQA_COLS
D_IN = sum(IN_COLS)

kernel_name = 'hybrid_gla_mla_gqa_diffusion_trunk'


def rms_norm(x, w):
    xf = x.astype(jnp.float32)
    y = xf * lax.rsqrt(jnp.mean(xf * xf, axis=-1, keepdims=True) + EPS)
    return (y * w.astype(jnp.float32)).astype(x.dtype)


def split_cols(u, sizes):
    idx = [int(i) for i in np.cumsum(sizes)[:-1]]
    return jnp.split(u, idx, axis=-1)


def rope_2d_tables(rows, d_rot):
    quarter = d_rot // 4
    row = jnp.repeat(jnp.arange(rows), GRID_W).astype(jnp.float32)
    col = jnp.tile(jnp.arange(GRID_W), rows).astype(jnp.float32)
    freqs = ROPE_THETA ** (-jnp.arange(quarter, dtype=jnp.float32) / quarter)
    ang = jnp.stack([row[:, None] * freqs, col[:, None] * freqs], axis=1)
    return jnp.cos(ang), jnp.sin(ang)


def apply_rope_2d(x, cos, sin):
    n, d = x.shape[1], x.shape[-1]
    q = d // 4
    xr = x.astype(jnp.float32).reshape(x.shape[:-1] + (2, 2, q))
    shape = (1, n) + (1,) * (x.ndim - 3) + (2, q)
    cos = cos.reshape(shape)
    sin = sin.reshape(shape)
    x1, x2 = xr[..., 0, :], xr[..., 1, :]
    out = jnp.stack([x1 * cos - x2 * sin, x2 * cos + x1 * sin], axis=-2)
    return out.reshape(x.shape).astype(x.dtype)


def attend(q, keys, vals, scale):
    s = jnp.einsum('bqhgd,bkhd->bhgqk', q, keys) * scale
    p = jax.nn.softmax(s.astype(jnp.float32), axis=-1).astype(vals.dtype)
    return jnp.einsum('bhgqk,bkhe->bqhge', p, vals)


def latent_attention(q, k, v, k_c, v_c, scale):
    keys = jnp.concatenate([k_c, k], axis=1)
    vals = jnp.concatenate([v_c, v], axis=1)
    b, n, hk, g, dq = q.shape
    nb = n // Q_BLOCK
    qb = jnp.moveaxis(q.reshape(b, nb, Q_BLOCK, hk, g, dq), 1, 0)
    o = lax.map(lambda qblk: attend(qblk, keys, vals, scale), qb)
    return jnp.moveaxis(o, 0, 1).reshape(b, n, hk, g, vals.shape[-1])


def gla_chunk_states(k, v, g, s0):
    bsz, t, h, dk = k.shape
    nc = t // GLA_CHUNK
    kc = k.reshape(bsz, nc, GLA_CHUNK, h, dk).astype(jnp.float32)
    vc = v.reshape(bsz, nc, GLA_CHUNK, h, v.shape[-1]).astype(jnp.float32)
    cum = jnp.cumsum(g.reshape(bsz, nc, GLA_CHUNK, h, dk), axis=2)
    last = cum[:, :, -1]
    ds = jnp.einsum('bnchk,bnchv->bnhkv', kc * jnp.exp(last[:, :, None] - cum), vc)

    def step(s, inp):
        decay, d = inp
        return jnp.exp(decay)[..., None] * s + d, s

    s_final, s_prev = lax.scan(step, s0, (jnp.moveaxis(last, 1, 0), jnp.moveaxis(ds, 1, 0)))
    return cum, jnp.moveaxis(s_prev, 0, 1), s_final


def gla_chunk_outputs(q, k, v, cum, s_prev):
    bsz, t, h, dk = q.shape
    dv = v.shape[-1]
    nc = t // GLA_CHUNK
    qc = q.reshape(bsz, nc, GLA_CHUNK, h, dk).astype(jnp.float32)
    kc = k.reshape(bsz, nc, GLA_CHUNK, h, dk).astype(jnp.float32)
    vc = v.reshape(bsz, nc, GLA_CHUNK, h, dv).astype(jnp.float32)
    q_dec = qc * jnp.exp(cum)
    k_inv = kc * jnp.exp(-cum)
    o_inter = jnp.einsum('bnchk,bnhkv->bnchv', q_dec, s_prev)
    a = jnp.einsum('bnihk,bnjhk->bnhij', q_dec, k_inv)
    mask = jnp.tril(jnp.ones((GLA_CHUNK, GLA_CHUNK), dtype=bool))
    a = jnp.where(mask, a, 0.0)
    o_intra = jnp.einsum('bnhij,bnjhv->bnihv', a, vc)
    return (o_inter + o_intra).reshape(bsz, t, h, dv).astype(v.dtype)


def gla_direction(lat, cx, want_ctx):
    q, k, v, g = lat
    qc, kc, vc, gc = cx
    s0 = jnp.zeros((kc.shape[0], GLA_HEADS, GLA_DK, GLA_DV), jnp.float32)
    cum_c, sp_c, sf_c = gla_chunk_states(kc, vc, gc, s0)
    cum, sp, _ = gla_chunk_states(k, v, g, sf_c)
    o = gla_chunk_outputs(q, k, v, cum, sp)
    oc = gla_chunk_outputs(qc, kc, vc, cum_c, sp_c) if want_ctx else None
    return o, oc


def gla_inputs(parts, w_a_f, b_a_f, w_a_b, b_a_b):
    q, k, v, _, a = parts
    bsz, t = q.shape[:2]
    hk = (bsz, t, GLA_HEADS, GLA_DK)
    q = q.reshape(hk) * GLA_DK ** -0.5
    k = k.reshape(hk)
    v = v.reshape(bsz, t, GLA_HEADS, GLA_DV)
    a_f, a_b = jnp.split(a, 2, axis=-1)
    g_f = (jax.nn.log_sigmoid((a_f @ w_a_f + b_a_f).astype(jnp.float32)) / GLA_GATE_NORM).reshape(hk)
    g_b = (jax.nn.log_sigmoid((a_b @ w_a_b + b_a_b).astype(jnp.float32)) / GLA_GATE_NORM).reshape(hk)
    return (q, k, v, g_f), (q, k, v, g_b)


def flip_t(ts):
    return tuple(jnp.flip(t, axis=1) for t in ts)


def gla_branch(parts, parts_c, w_a_f, b_a_f, w_a_b, b_a_b, norm_w, want_ctx):
    lat_f, lat_b = gla_inputs(parts, w_a_f, b_a_f, w_a_b, b_a_b)
    cx_f, cx_b = gla_inputs(parts_c, w_a_f, b_a_f, w_a_b, b_a_b)
    o_f, oc_f = gla_direction(lat_f, cx_f, want_ctx)
    o_b, oc_b = gla_direction(flip_t(lat_b), flip_t(cx_b), want_ctx)

    def finish(o_fwd, o_bwd, z):
        o = rms_norm(o_fwd + jnp.flip(o_bwd, axis=1), norm_w)
        return o.reshape(z.shape) * jax.nn.silu(z)

    y = finish(o_f, o_b, parts[3])
    yc = finish(oc_f, oc_b, parts_c[3]) if want_ctx else None
    return y, yc


def mla_project(parts, q_norm_w, w_uq, kv_norm_w, w_ukv, cos, sin, rotate):
    cq, ckv, kr, _ = parts
    bsz, t = cq.shape[:2]
    q = (rms_norm(cq, q_norm_w) @ w_uq).reshape(bsz, t, MLA_HEADS, MLA_NOPE + MLA_ROPE)
    kv = (rms_norm(ckv, kv_norm_w) @ w_ukv).reshape(bsz, t, MLA_HEADS, MLA_NOPE + MLA_V)
    q_nope, q_rope = q[..., :MLA_NOPE], q[..., MLA_NOPE:]
    k_nope, v = kv[..., :MLA_NOPE], kv[..., MLA_NOPE:]
    k_rope = kr[:, :, None, :]
    if rotate:
        q_rope = apply_rope_2d(q_rope, cos, sin)
        k_rope = apply_rope_2d(k_rope, cos, sin)
    q = jnp.concatenate([q_nope, q_rope], axis=-1)
    k = jnp.concatenate([k_nope, jnp.broadcast_to(k_rope, (bsz, t, MLA_HEADS, MLA_ROPE))], axis=-1)
    return q, k, v


def mla_branch(parts, parts_c, q_norm_w, w_uq, kv_norm_w, w_ukv, cos, sin, want_ctx):
    scale = (MLA_NOPE + MLA_ROPE) ** -0.5
    q, k, v = mla_project(parts, q_norm_w, w_uq, kv_norm_w, w_ukv, cos, sin, True)
    qc, kc, vc = mla_project(parts_c, q_norm_w, w_uq, kv_norm_w, w_ukv, None, None, False)
    z, zc = parts[3], parts_c[3]
    y = latent_attention(q[:, :, :, None], k, v, kc, vc, scale).reshape(z.shape) * jax.nn.silu(z)
    yc = attend(qc[:, :, :, None], kc, vc, scale).reshape(zc.shape) * jax.nn.silu(zc) if want_ctx else None
    return y, yc


def gqa_project(parts, q_norm_w, k_norm_w, cos, sin, rotate):
    q, k, v, _ = parts
    bsz, t = q.shape[:2]
    q = rms_norm(q.reshape(bsz, t, GQA_HEADS, HEAD_DIM), q_norm_w)
    k = rms_norm(k.reshape(bsz, t, GQA_KV_HEADS, HEAD_DIM), k_norm_w)
    v = v.reshape(bsz, t, GQA_KV_HEADS, HEAD_DIM)
    if rotate:
        q = apply_rope_2d(q, cos, sin)
        k = apply_rope_2d(k, cos, sin)
    return q.reshape(bsz, t, GQA_KV_HEADS, GQA_GROUP, HEAD_DIM), k, v


def gqa_branch(parts, parts_c, q_norm_w, k_norm_w, cos, sin, want_ctx):
    scale = HEAD_DIM ** -0.5
    q, k, v = gqa_project(parts, q_norm_w, k_norm_w, cos, sin, True)
    qc, kc, vc = gqa_project(parts_c, q_norm_w, k_norm_w, None, None, False)
    z, zc = parts[3], parts_c[3]
    y = latent_attention(q, k, v, kc, vc, scale).reshape(z.shape) * jax.nn.silu(z)
    yc = attend(qc, kc, vc, scale).reshape(zc.shape) * jax.nn.silu(zc) if want_ctx else None
    return y, yc


def setup_inputs(seed: int = 0) -> dict:
    key = jax.random.key(seed)
    ks = jax.random.split(key, 24)
    f32 = jnp.float32
    L = DEPTH

    def nrm(k, shape, s):
        return jax.random.normal(k, shape, f32) * s

    def gain(k, shape):
        return 1.0 + 0.02 * jax.random.normal(k, shape, f32)

    return {
        'x': nrm(ks[0], (BATCH, SEQ, D_MODEL), 1.0),
        'c': nrm(ks[1], (BATCH, D_MODEL), 1.0),
        'ctx': nrm(ks[2], (BATCH, CTX_LEN, D_MODEL), 1.0),
        'c_ctx': nrm(ks[3], (D_MODEL,), 1.0),
        'norm_w': gain(ks[4], (L, D_MODEL)),
        'w_mod': nrm(ks[5], (L, D_MODEL, 3 * D_MODEL), D_MODEL ** -0.5),
        'b_mod': nrm(ks[6], (L, 3 * D_MODEL), 0.01),
        'w_in': nrm(ks[7], (L, D_MODEL, D_IN), D_MODEL ** -0.5),
        'gla_w_a_fwd': nrm(ks[8], (L, GLA_GATE_RANK, GLA_HEADS * GLA_DK), GLA_GATE_RANK ** -0.5),
        'gla_b_a_fwd': nrm(ks[9], (L, GLA_HEADS * GLA_DK), 0.1),
        'gla_w_a_bwd': nrm(ks[10], (L, GLA_GATE_RANK, GLA_HEADS * GLA_DK), GLA_GATE_RANK ** -0.5),
        'gla_b_a_bwd': nrm(ks[11], (L, GLA_HEADS * GLA_DK), 0.1),
        'gla_norm_w': gain(ks[12], (L, GLA_DV)),
        'mla_q_norm_w': gain(ks[13], (L, MLA_Q_LORA)),
        'mla_w_uq': nrm(ks[14], (L, MLA_Q_LORA, MLA_HEADS * (MLA_NOPE + MLA_ROPE)), MLA_Q_LORA ** -0.5),
        'mla_kv_norm_w': gain(ks[15], (L, MLA_KV_LORA)),
        'mla_w_ukv': nrm(ks[16], (L, MLA_KV_LORA, MLA_HEADS * (MLA_NOPE + MLA_V)), MLA_KV_LORA ** -0.5),
        'gqa_q_norm_w': gain(ks[17], (L, HEAD_DIM)),
        'gqa_k_norm_w': gain(ks[18], (L, HEAD_DIM)),
        'w_out': nrm(ks[19], (L, D_MIX, D_MODEL), D_MIX ** -0.5),
        'final_norm_w': gain(ks[20], (D_MODEL,)),
    }


def reference(x, c, ctx, c_ctx, norm_w, w_mod, b_mod, w_in, gla_w_a_fwd, gla_b_a_fwd, gla_w_a_bwd,
              gla_b_a_bwd, gla_norm_w, mla_q_norm_w, mla_w_uq, mla_kv_norm_w, mla_w_ukv,
              gqa_q_norm_w, gqa_k_norm_w, w_out, final_norm_w):
    n = x.shape[1]
    rows = n // GRID_W
    cos_m, sin_m = rope_2d_tables(rows, MLA_ROPE)
    cos_g, sin_g = rope_2d_tables(rows, HEAD_DIM)
    n_a = len(GLA_COLS)
    n_b = n_a + len(MLA_COLS)
    for l in range(DEPTH):
        want_ctx = l < DEPTH - 1
        shift, scale, gate = jnp.split(jax.nn.silu(c) @ w_mod[l] + b_mod[l], 3, axis=-1)
        shift_c, scale_c, gate_c = jnp.split(jax.nn.silu(c_ctx) @ w_mod[l] + b_mod[l], 3, axis=-1)
        h = rms_norm(x, norm_w[l]) * (1.0 + scale[:, None, :]) + shift[:, None, :]
        hc = rms_norm(ctx, norm_w[l]) * (1.0 + scale_c) + shift_c
        u = split_cols(h @ w_in[l], IN_COLS)
        uc = split_cols(hc @ w_in[l], IN_COLS)
        y_a, yc_a = gla_branch(u[:n_a], uc[:n_a], gla_w_a_fwd[l], gla_b_a_fwd[l], gla_w_a_bwd[l],
                               gla_b_a_bwd[l], gla_norm_w[l], want_ctx)
        y_b, yc_b = mla_branch(u[n_a:n_b], uc[n_a:n_b], mla_q_norm_w[l], mla_w_uq[l], mla_kv_norm_w[l],
                               mla_w_ukv[l], cos_m, sin_m, want_ctx)
        y_c, yc_c = gqa_branch(u[n_b:], uc[n_b:], gqa_q_norm_w[l], gqa_k_norm_w[l], cos_g, sin_g, want_ctx)
        x = x + gate[:, None, :] * (jnp.concatenate([y_a, y_b, y_c], axis=-1) @ w_out[l])
        if want_ctx:
            ctx = ctx + gate_c * (jnp.concatenate([yc_a, yc_b, yc_c], axis=-1) @ w_out[l])
    return rms_norm(x, final_norm_w)
```

```cpp
#include <hip/hip_runtime.h>
#include <hip/hip_cooperative_groups.h>
#include <stdint.h>
#include <cstdio>
namespace cg = cooperative_groups;

#ifndef MK_MODE
#define MK_MODE 1
#endif

typedef unsigned short u16;
typedef short bf16x8 __attribute__((ext_vector_type(8)));
typedef float f32x16 __attribute__((ext_vector_type(16)));
typedef __bf16 bf2_t __attribute__((ext_vector_type(2)));
typedef float f2_t __attribute__((ext_vector_type(2)));
typedef uint32_t u32x4 __attribute__((ext_vector_type(4)));
typedef uint32_t u32x2 __attribute__((ext_vector_type(2)));
#define DI __device__ __forceinline__
#define MFMA(a, b, c) __builtin_amdgcn_mfma_f32_32x32x16_bf16((a), (b), (c), 0, 0, 0)

constexpr int DM = 1024, NB = 8, SEQ = 4096, CTXL = 256, TALL = 4352, NLAT = NB * SEQ, TT = NLAT + NB * CTXL, DEPTH = 4;
constexpr int NIN = 2816, DIN_SRC = 2752;
constexpr int C_CQ = 0, C_CKV = 256, C_GQ = 512, C_GK = 896, C_GV = 1024, C_LQ = 1152, C_LK = 1280, C_LV = 1408, C_LA = 1664, C_KR = 1696, C_Z = 1792;
constexpr float EPS = 1e-6f;
constexpr float LOG2E = 1.4426950408889634f;
constexpr int NPHASE = 2 + 5 * DEPTH + 1;

constexpr size_t SZ_WIN = (size_t)4 * NIN * 1024 * 2, SZ_WOUT = (size_t)4 * 1024 * 1024 * 2, SZ_WUQ = (size_t)4 * 640 * 256 * 2, SZ_WUKV = (size_t)4 * 768 * 256 * 2;
constexpr size_t SZ_MOD = (size_t)4 * 9 * 3072 * 4, SZ_BIAS = (size_t)4 * 9 * NIN * 4, SZ_ROPE = 12288, SZ_RSS = (size_t)TT * 16 * 4, SZ_CSS = (size_t)TT * 8 * 4;
constexpr size_t SZ_CTXX = (size_t)2048 * 1024 * 4, SZ_XG = (size_t)TT * 1024 * 2, SZ_U = (size_t)TT * NIN * 2;
constexpr size_t SZ_QM = (size_t)NB * 6 * TALL * 96 * 2, SZ_QG = (size_t)NB * 6 * TALL * 64 * 2, SZ_VTM = (size_t)NB * 6 * 64 * TALL * 2, SZ_KG = (size_t)NB * 2 * TALL * 64 * 2;
constexpr size_t SZ_CUM = (size_t)2 * TT * 128 * 4, SZ_DS = (size_t)2 * NB * 68 * 4 * 2048 * 4, SZ_LAST = (size_t)2 * NB * 68 * 4 * 32 * 4;
constexpr size_t OFF_WIN = 0, OFF_WOUT = OFF_WIN + SZ_WIN, OFF_WUQ = OFF_WOUT + SZ_WOUT, OFF_WUKV = OFF_WUQ + SZ_WUQ, OFF_MOD = OFF_WUKV + SZ_WUKV, OFF_BIAS = OFF_MOD + SZ_MOD,
                 OFF_ROPE = OFF_BIAS + SZ_BIAS, OFF_RSS = OFF_ROPE + SZ_ROPE, OFF_CSS = OFF_RSS + SZ_RSS, OFF_CTXX = OFF_CSS + SZ_CSS, OFF_XG = OFF_CTXX + SZ_CTXX,
                 OFF_QM = OFF_XG, OFF_QG = OFF_XG + SZ_QM,
                 OFF_U = OFF_XG + SZ_XG, OFF_KM = OFF_U + SZ_U, OFF_VTM = OFF_KM + SZ_QM, OFF_KG = OFF_VTM + SZ_VTM, OFF_VTG = OFF_KG + SZ_KG, OFF_CUM = OFF_VTG + SZ_KG,
                 OFF_DS = OFF_CUM + SZ_CUM, OFF_LAST = OFF_DS + SZ_DS, OFF_SPREV = OFF_LAST + SZ_LAST, OFF_BAR = OFF_SPREV + SZ_DS, SZ_BAR = (3456 + 64 * 64) * 4, WS_TOTAL = OFF_BAR + SZ_BAR;
static_assert(SZ_QM + SZ_QG <= SZ_XG, "Q overlay");

struct Params {
    const float *x, *c, *ctx, *c_ctx, *norm_w, *w_mod, *b_mod, *w_in, *wa_f, *ba_f, *wa_b, *ba_b, *gla_nw, *mla_qnw, *w_uq, *mla_kvnw, *w_ukv, *gqa_qnw, *gqa_knw, *w_out, *final_nw;
    float* out;
    char* ws;
    int phase_begin, phase_end;
};

DI uint32_t pack2(float a, float b) { f2_t v = {a, b}; bf2_t r = __builtin_convertvector(v, bf2_t); return __builtin_bit_cast(uint32_t, r); }
DI u16 f2bf(float a) { return (u16)(pack2(a, 0.f) & 0xffffu); }
DI float bf2f(u16 v) { return __uint_as_float((uint32_t)v << 16); }
DI float bflo(uint32_t v) { return __uint_as_float(v << 16); }
DI float bfhi(uint32_t v) { return __uint_as_float(v & 0xffff0000u); }
DI int otid() { int t = threadIdx.x; asm volatile("" : "+v"(t)); return t; }
DI float xhalf_max(float x) { const unsigned u = __float_as_uint(x); auto r = __builtin_amdgcn_permlane32_swap(u, u, false, false); return fmaxf(__uint_as_float(r[0]), __uint_as_float(r[1])); }
DI float xhalf_sum(float x) { const unsigned u = __float_as_uint(x); auto r = __builtin_amdgcn_permlane32_swap(u, u, false, false); return __uint_as_float(r[0]) + __uint_as_float(r[1]); }
DI float max3f(float a, float b, float c) { float r; asm("v_max3_f32 %0, %1, %2, %3" : "=v"(r) : "v"(a), "v"(b), "v"(c)); return r; }
DI u32x4 pair16(u32x2 lo, u32x2 hi) {
    auto a = __builtin_amdgcn_permlane32_swap(lo.x, hi.x, false, false);
    auto b = __builtin_amdgcn_permlane32_swap(lo.y, hi.y, false, false);
    u32x4 r; r.x = a[0]; r.y = b[0]; r.z = a[1]; r.w = b[1]; return r;
}
DI void mfence() { asm volatile("" ::: "memory"); }
DI float silu(float v) { return v / (1.f + __expf(-v)); }
DI float wave_sum(float v) {
    v += __shfl_xor(v, 1); v += __shfl_xor(v, 2); v += __shfl_xor(v, 4); v += __shfl_xor(v, 8); v += __shfl_xor(v, 16); v += __shfl_xor(v, 32); return v;
}
DI int srccol(int n) {
    if (n < 256) return 800 + n;
    if (n < 512) return 1056 + n - 256;
    if (n < 896) return 1728 + n - 512;
    if (n < 1024) return 2112 + n - 896;
    if (n < 1152) return 2240 + n - 1024;
    if (n < 1280) return n - 1152;
    if (n < 1408) return 128 + n - 1280;
    if (n < 1664) return 256 + n - 1408;
    if (n < 1696) return 768 + n - 1664;
    if (n < 1728) return 1312 + n - 1696;
    if (n < 1792) return -1;
    if (n < 2048) return 512 + n - 1792;
    if (n < 2432) return 1344 + n - 2048;
    return 2368 + n - 2432;
}
struct RowInfo { int b, t, tall, lat; };
DI RowInfo rowinfo(int row) {
    RowInfo r;
    if (row < NLAT) { r.b = row >> 12; r.t = row & 4095; r.tall = 256 + r.t; r.lat = 1; }
    else { int rr = row - NLAT; r.b = rr >> 8; r.t = rr & 255; r.tall = r.t; r.lat = 0; }
    return r;
}

constexpr int TM = 256;
struct NoPrefetch { DI void operator()() const {} };
template <class PF = NoPrefetch>
DI void gemm_core(const u16* __restrict__ Wp, int ldw, const u16* __restrict__ Xp, int ldx, int K, u16* sbase, f32x16 (&acc)[2][4], PF&& pf = PF()) {
    const int tid = otid(), wave = tid >> 6, lane = tid & 63, r = lane & 31, h = lane >> 5, wf = wave & 1, wt = wave >> 1;
    const int lrow = tid >> 3, lc = (tid & 7) * 8;
    const u16* wsrc = Wp + (size_t)lrow * ldw + lc;
    const u16* xsrc = Xp + (size_t)lrow * ldx + lc;
    u16* sW = sbase; u16* sX = sbase + 128 * 72;
    const int nk = K >> 6;
    u32x4 rg[12];
#define G_LOAD(kt) { _Pragma("unroll") for (int i = 0; i < 4; ++i) rg[i] = *(const u32x4*)(wsrc + (size_t)(32 * i) * ldw + (kt) * 64); \
                     _Pragma("unroll") for (int i = 0; i < 8; ++i) rg[4 + i] = *(const u32x4*)(xsrc + (size_t)(32 * i) * ldx + (kt) * 64); }
#define G_STORE() { _Pragma("unroll") for (int i = 0; i < 4; ++i) *(u32x4*)(sW + (lrow + 32 * i) * 72 + lc) = rg[i]; \
                    _Pragma("unroll") for (int i = 0; i < 8; ++i) *(u32x4*)(sX + (lrow + 32 * i) * 72 + lc) = rg[4 + i]; }
#define G_FRAGS(F, ks) { _Pragma("unroll") for (int q = 0; q < 2; ++q) F[q] = *(const bf16x8*)(sW + (wf * 64 + q * 32 + r) * 72 + (ks) * 16 + h * 8); \
                         _Pragma("unroll") for (int q = 0; q < 4; ++q) F[2 + q] = *(const bf16x8*)(sX + (wt * 128 + q * 32 + r) * 72 + (ks) * 16 + h * 8); }
#define G_MMA(F) { _Pragma("unroll") for (int fb = 0; fb < 2; ++fb) _Pragma("unroll") for (int tb = 0; tb < 4; ++tb) acc[fb][tb] = MFMA(F[fb], F[2 + tb], acc[fb][tb]); }
#define SCHED_FENCE() __builtin_amdgcn_sched_barrier(0)
    G_LOAD(0);
    for (int k = 0; k < nk; ++k) {
        __syncthreads();
        G_STORE();
        __syncthreads();
        {
            bf16x8 fa[6]; G_FRAGS(fa, 0); SCHED_FENCE();
            if (k + 1 < nk) { G_LOAD(k + 1); } else { pf(); }
            SCHED_FENCE(); G_MMA(fa); SCHED_FENCE();
        }
#pragma unroll
        for (int ks = 1; ks < 4; ++ks) { bf16x8 fa[6]; G_FRAGS(fa, ks); SCHED_FENCE(); G_MMA(fa); SCHED_FENCE(); }
    }
#undef G_LOAD
#undef G_STORE
#undef G_FRAGS
#undef G_MMA
#undef SCHED_FENCE
}
DI void zero_acc(f32x16 (&acc)[2][4]) {
#pragma unroll
    for (int a = 0; a < 2; ++a)
#pragma unroll
        for (int b = 0; b < 4; ++b)
#pragma unroll
            for (int i = 0; i < 16; ++i) acc[a][b][i] = 0.f;
}

DI void tconv_tile(const float* __restrict__ src, int ldsrc, int nsrc, int mode, int k0, int n0, const float* __restrict__ kscale, u16* __restrict__ dst, int lddst, float* sm) {
    const int tid = otid();
    __syncthreads();
#pragma unroll 4
    for (int i = 0; i < 16; ++i) {
        const int idx = tid + 256 * i, kk = idx >> 6, nn = idx & 63, n = n0 + nn;
        const int sc = mode ? srccol(n) : (n < nsrc ? n : -1);
        float v = 0.f;
        if (sc >= 0) v = src[(size_t)(k0 + kk) * ldsrc + sc];
        if (kscale) v *= kscale[k0 + kk];
        sm[kk * 65 + nn] = v;
    }
    __syncthreads();
#pragma unroll 4
    for (int i = 0; i < 8; ++i) {
        const int idx = tid + 256 * i, nn = idx >> 5, kp = idx & 31;
        *(uint32_t*)(dst + (size_t)(n0 + nn) * lddst + k0 + 2 * kp) = pack2(sm[(2 * kp) * 65 + nn], sm[(2 * kp + 1) * 65 + nn]);
    }
}

constexpr int N_WCONV = 704 + 256 + 40 + 48;
DI void wconv_item(const Params& p, int l, int i, float* smf) {
    if (i < 704) { const int nt = i / 16, kt = i % 16;
        tconv_tile(p.w_in + (size_t)l * 1024 * DIN_SRC, DIN_SRC, DIN_SRC, 1, kt * 64, nt * 64, nullptr, (u16*)(p.ws + OFF_WIN) + (size_t)l * NIN * 1024, 1024, smf); return; }
    i -= 704;
    if (i < 256) { const int nt = i / 16, kt = i % 16;
        tconv_tile(p.w_out + (size_t)l * 1024 * 1024, 1024, 1024, 0, kt * 64, nt * 64, nullptr, (u16*)(p.ws + OFF_WOUT) + (size_t)l * 1024 * 1024, 1024, smf); return; }
    i -= 256;
    if (i < 40) { const int nt = i / 4, kt = i % 4;
        tconv_tile(p.w_uq + (size_t)l * 256 * 576, 576, 576, 0, kt * 64, nt * 64, p.mla_qnw + l * 256, (u16*)(p.ws + OFF_WUQ) + (size_t)l * 640 * 256, 256, smf); return; }
    i -= 40;
    { const int nt = i / 4, kt = i % 4;
        tconv_tile(p.w_ukv + (size_t)l * 256 * 768, 768, 768, 0, kt * 64, nt * 64, p.mla_kvnw + l * 256, (u16*)(p.ws + OFF_WUKV) + (size_t)l * 768 * 256, 256, smf); }
}
DI void bias_item(const Params& p, int l, int cgp, char* smem) {
    const int tid = otid();
    float* smf = (float*)smem;
    const float* MOD = (const float*)(p.ws + OFF_MOD);
    __syncthreads();
    for (int idx = tid; idx < 9 * 1024; idx += 256) smf[idx] = MOD[(size_t)(l * 9 + (idx >> 10)) * 3072 + (idx & 1023)];
    __syncthreads();
    const int kg = tid >> 4, q = tid & 15, sc = srccol(cgp * 64 + q * 4);
    float acc[9][4];
#pragma unroll
    for (int j = 0; j < 9; ++j) { acc[j][0] = 0.f; acc[j][1] = 0.f; acc[j][2] = 0.f; acc[j][3] = 0.f; }
    if (sc >= 0) {
        const float* wp = p.w_in + ((size_t)l * 1024 + kg * 64) * DIN_SRC + sc;
#pragma unroll 8
        for (int kk = 0; kk < 64; ++kk) {
            const float4 w = *(const float4*)(wp + (size_t)kk * DIN_SRC);
#pragma unroll
            for (int j = 0; j < 9; ++j) { const float sv = smf[j * 1024 + kg * 64 + kk]; acc[j][0] += sv * w.x; acc[j][1] += sv * w.y; acc[j][2] += sv * w.z; acc[j][3] += sv * w.w; }
        }
    }
    __syncthreads();
#pragma unroll
    for (int j = 0; j < 9; ++j) *(float4*)(smf + (kg * 9 + j) * 64 + q * 4) = make_float4(acc[j][0], acc[j][1], acc[j][2], acc[j][3]);
    __syncthreads();
    float* BIAS = (float*)(p.ws + OFF_BIAS);
    for (int idx = tid; idx < 9 * 64; idx += 256) {
        const int j = idx >> 6, ln = idx & 63;
        float sm = 0.f;
#pragma unroll
        for (int g = 0; g < 16; ++g) sm += smf[(g * 9 + j) * 64 + ln];
        BIAS[(size_t)(l * 9 + j) * NIN + cgp * 64 + ln] = sm;
    }
}

DI void phase0(const Params& p, char* smem) {
    const int tid = otid(), wave = tid >> 6, lane = tid & 63;
    float* smf = (float*)smem;
    constexpr int N_MOD = 4 * 48;
    constexpr int TOT = N_MOD + N_WCONV + 1;
    for (int it = blockIdx.x; it < TOT; it += gridDim.x) {
        int i = it;
        if (i < N_MOD) {
            const int l = i / 48, cgp = i % 48;
            __syncthreads();
            for (int idx = tid; idx < 9 * 1024; idx += 256) {
                const int j = idx >> 10, k = idx & 1023;
                const float cv = j < 8 ? p.c[j * 1024 + k] : p.c_ctx[k];
                smf[idx] = silu(cv);
            }
            __syncthreads();
            const int kg = tid >> 4, q = tid & 15;
            float acc[9][4];
#pragma unroll
            for (int j = 0; j < 9; ++j) { acc[j][0] = 0.f; acc[j][1] = 0.f; acc[j][2] = 0.f; acc[j][3] = 0.f; }
            const float* wp = p.w_mod + ((size_t)l * 1024 + kg * 64) * 3072 + cgp * 64 + q * 4;
#pragma unroll 8
            for (int kk = 0; kk < 64; ++kk) {
                const float4 w = *(const float4*)(wp + (size_t)kk * 3072);
#pragma unroll
                for (int j = 0; j < 9; ++j) { const float sv = smf[j * 1024 + kg * 64 + kk]; acc[j][0] += sv * w.x; acc[j][1] += sv * w.y; acc[j][2] += sv * w.z; acc[j][3] += sv * w.w; }
            }
            __syncthreads();
#pragma unroll
            for (int j = 0; j < 9; ++j) *(float4*)(smf + (kg * 9 + j) * 64 + q * 4) = make_float4(acc[j][0], acc[j][1], acc[j][2], acc[j][3]);
            __syncthreads();
            float* MOD = (float*)(p.ws + OFF_MOD);
            for (int idx = tid; idx < 9 * 64; idx += 256) {
                const int j = idx >> 6, ln = idx & 63;
                float sm = p.b_mod[l * 3072 + cgp * 64 + ln];
#pragma unroll
                for (int g = 0; g < 16; ++g) sm += smf[(g * 9 + j) * 64 + ln];
                MOD[(size_t)(l * 9 + j) * 3072 + cgp * 64 + ln] = sm;
            }
            continue;
        }
        i -= N_MOD;
        if (i < N_WCONV) { wconv_item(p, 0, i, smf); continue; }
        {
            float* rope = (float*)(p.ws + OFF_ROPE);
            for (int idx = tid; idx < 64 * 16 + 64 * 8; idx += 256) {
                int pos, f, quarter; float *cd, *sd;
                if (idx < 1024) { pos = idx >> 4; f = idx & 15; quarter = 16; cd = rope + idx; sd = rope + 1024 + idx; }
                else { const int j = idx - 1024; pos = j >> 3; f = j & 7; quarter = 8; cd = rope + 2048 + j; sd = rope + 2560 + j; }
                const float freq = exp2f(-(float)f / (float)quarter * 13.287712379549449f);
                const float ang = (float)pos * freq;
                float rev = ang * 0.15915494309189535f; rev -= rintf(rev);
                *cd = __builtin_amdgcn_cosf(rev); *sd = __builtin_amdgcn_sinf(rev);
            }
        }
    }
}

DI void phase1(const Params& p, char* smem) {
    const int tid = otid(), wave = tid >> 6, lane = tid & 63;
    float* smf = (float*)smem;
    const float* MOD = (const float*)(p.ws + OFF_MOD);
    constexpr int N_ROWS = TT / 32, N_BIAS = 44;
    for (int it = blockIdx.x; it < N_ROWS + N_BIAS; it += gridDim.x) {
        if (it < N_BIAS) { bias_item(p, 0, it, smem); continue; }
        const int row0 = (it - N_BIAS) * 32 + wave * 8;
        const int j = row0 < NLAT ? (row0 >> 12) : 8;
        float4 g[4];
#pragma unroll
        for (int i = 0; i < 4; ++i) {
            const int col = lane * 4 + 256 * i;
            const float4 nw = *(const float4*)(p.norm_w + col), sc = *(const float4*)(MOD + (size_t)j * 3072 + 1024 + col);
            g[i] = make_float4(nw.x * (1.f + sc.x), nw.y * (1.f + sc.y), nw.z * (1.f + sc.z), nw.w * (1.f + sc.w));
        }
        for (int rr = 0; rr < 8; ++rr) {
            const int row = row0 + rr;
            const float* src = row < NLAT ? p.x + (size_t)row * 1024 : p.ctx + (size_t)(row - NLAT) * 1024;
            float ss = 0.f;
#pragma unroll
            for (int i = 0; i < 4; ++i) {
                const int col = lane * 4 + 256 * i;
                const float4 v = *(const float4*)(src + col);
                ss += v.x * v.x + v.y * v.y + v.z * v.z + v.w * v.w;
                u32x2 o; o.x = pack2(v.x * g[i].x, v.y * g[i].y); o.y = pack2(v.z * g[i].z, v.w * g[i].w);
                *(u32x2*)((u16*)(p.ws + OFF_XG) + (size_t)row * 1024 + col) = o;
                if (row >= NLAT) *(float4*)((float*)(p.ws + OFF_CTXX) + (size_t)(row - NLAT) * 1024 + col) = v;
            }
            ss = wave_sum(ss);
            if (lane < 16) ((float*)(p.ws + OFF_RSS))[(size_t)row * 16 + lane] = lane == 0 ? ss : 0.f;
        }
    }
}

DI void inproj_tile(const Params& p, int l, int mt, int nt, char* smem) {
    const int tid = otid(), wave = tid >> 6, lane = tid & 63, r = lane & 31, h = lane >> 5, wf = wave & 1, wt = wave >> 1;
    u16* sW = (u16*)smem;
    f32x16 acc[2][4]; zero_acc(acc);
    const int j = mt < 128 ? (mt >> 4) : 8;
    const float* bias = (const float*)(p.ws + OFF_BIAS) + (size_t)(l * 9 + j) * NIN;
    const float* RSS = (const float*)(p.ws + OFF_RSS);
    const int n0 = nt * 128 + wf * 64;
    float4 rs4[4][4], bv4[2][4];
    gemm_core((const u16*)(p.ws + OFF_WIN) + ((size_t)l * NIN + nt * 128) * 1024, 1024, (const u16*)(p.ws + OFF_XG) + (size_t)mt * TM * 1024, 1024, 1024, sW, acc, [&]() {
#pragma unroll
        for (int tb = 0; tb < 4; ++tb)
#pragma unroll
            for (int q = 0; q < 4; ++q) rs4[tb][q] = *(const float4*)(RSS + (size_t)(mt * TM + wt * 128 + tb * 32 + r) * 16 + 4 * q);
#pragma unroll
        for (int fb = 0; fb < 2; ++fb)
#pragma unroll
            for (int g4 = 0; g4 < 4; ++g4) bv4[fb][g4] = *(const float4*)(bias + n0 + fb * 32 + 8 * g4 + 4 * h);
    });
    u16* U = (u16*)(p.ws + OFF_U);
    u16* sO = (u16*)smem;
    __syncthreads();
#pragma unroll
    for (int tb = 0; tb < 4; ++tb) {
        const int row = mt * TM + wt * 128 + tb * 32 + r;
        float s = 0.f;
#pragma unroll
        for (int q = 0; q < 4; ++q) { const float4 v = rs4[tb][q]; s += (v.x + v.y) + (v.z + v.w); }
        const float rstd = rsqrtf(s * (1.f / 1024.f) + EPS);
        float ss = 0.f;
#pragma unroll
        for (int fb = 0; fb < 2; ++fb)
#pragma unroll
            for (int g4 = 0; g4 < 4; ++g4) {
                const int n = n0 + fb * 32 + 8 * g4 + 4 * h;
                const float4 bv = bv4[fb][g4];
                const float v0 = acc[fb][tb][4 * g4 + 0] * rstd + bv.x, v1 = acc[fb][tb][4 * g4 + 1] * rstd + bv.y, v2 = acc[fb][tb][4 * g4 + 2] * rstd + bv.z,
                            v3 = acc[fb][tb][4 * g4 + 3] * rstd + bv.w;
                ss += v0 * v0 + v1 * v1 + v2 * v2 + v3 * v3;
                u32x2 o; o.x = pack2(v0, v1); o.y = pack2(v2, v3);
                *(u32x2*)(sO + (wt * 128 + tb * 32 + r) * 136 + wf * 64 + fb * 32 + 8 * g4 + 4 * h) = o;
            }
        if (nt < 4) {
            ss += __shfl_xor(ss, 32);
            if (h == 0) ((float*)(p.ws + OFF_CSS))[(size_t)row * 8 + nt * 2 + wf] = ss;
        }
    }
    __syncthreads();
#pragma unroll 4
    for (int i = 0; i < 16; ++i) {
        const int idx = tid + 256 * i, rr = idx >> 4, ch = idx & 15;
        *(u32x4*)(U + (size_t)(mt * TM + rr) * NIN + nt * 128 + ch * 8) = *(const u32x4*)(sO + rr * 136 + ch * 8);
    }
}

DI void upproj_tile(const Params& p, int l, int mt, int nt, char* smem) {
    const int tid = otid(), wave = tid >> 6, lane = tid & 63, r = lane & 31, h = lane >> 5, wf = wave & 1, wt = wave >> 1;
    u16* sW = (u16*)smem;
    f32x16 acc[2][4]; zero_acc(acc);
    const u16* U = (const u16*)(p.ws + OFF_U);
    const bool isq = nt < 5;
    const u16* W = isq ? (const u16*)(p.ws + OFF_WUQ) + ((size_t)l * 640 + nt * 128) * 256 : (const u16*)(p.ws + OFF_WUKV) + ((size_t)l * 768 + (nt - 5) * 128) * 256;
    gemm_core(W, 256, U + (size_t)mt * TM * NIN + (isq ? C_CQ : C_CKV), NIN, 256, sW, acc);
    const float* CSS = (const float*)(p.ws + OFF_CSS);
    const float* rope = (const float*)(p.ws + OFF_ROPE);
    u16* QM = (u16*)(p.ws + OFF_QM); u16* KM = (u16*)(p.ws + OFF_KM); u16* VTM = (u16*)(p.ws + OFF_VTM);
#pragma unroll
    for (int tb = 0; tb < 4; ++tb) {
        const int row = mt * TM + wt * 128 + tb * 32 + r;
        const RowInfo ri = rowinfo(row);
        const float4 cs4 = *(const float4*)(CSS + (size_t)row * 8 + (isq ? 0 : 4));
        float rstd = rsqrtf(((cs4.x + cs4.y) + (cs4.z + cs4.w)) * (1.f / 256.f) + EPS);
        if (isq) {
            rstd *= 0.10206207261596577f * LOG2E;
#pragma unroll
            for (int fb = 0; fb < 2; ++fb)
#pragma unroll
                for (int hh = 0; hh < 2; ++hh) {
                    const int n16 = nt * 128 + wf * 64 + fb * 32 + 16 * hh;
                    if (n16 >= 576) continue;
                    const int head = n16 / 96, d16 = n16 - head * 96;
                    float lo[4], hi[4];
#pragma unroll
                    for (int e = 0; e < 4; ++e) { lo[e] = acc[fb][tb][8 * hh + e] * rstd; hi[e] = acc[fb][tb][8 * hh + 4 + e] * rstd; }
                    if (d16 >= 64 && ri.lat) {
                        const int axis = (d16 - 64) >> 4, pos = axis ? (ri.t & 63) : (ri.t >> 6);
                        const float4 c4 = *(const float4*)(rope + 2048 + pos * 8 + 4 * h), s4 = *(const float4*)(rope + 2560 + pos * 8 + 4 * h);
                        const float cc[4] = {c4.x, c4.y, c4.z, c4.w}, sn[4] = {s4.x, s4.y, s4.z, s4.w};
#pragma unroll
                        for (int e = 0; e < 4; ++e) { const float x1 = lo[e], x2 = hi[e]; lo[e] = x1 * cc[e] - x2 * sn[e]; hi[e] = x2 * cc[e] + x1 * sn[e]; }
                    }
                    u16* dst = QM + ((size_t)(ri.b * 6 + head) * TALL + ri.tall) * 96 + d16 + 8 * h;
                    u32x2 ol, oh; ol.x = pack2(lo[0], lo[1]); ol.y = pack2(lo[2], lo[3]); oh.x = pack2(hi[0], hi[1]); oh.y = pack2(hi[2], hi[3]);
                    *(u32x4*)dst = pair16(ol, oh);
                }
        } else {
            const int head = nt - 5;
            if (wf == 0) {
                u16* dst = KM + ((size_t)(ri.b * 6 + head) * TALL + ri.tall) * 96;
#pragma unroll
                for (int fb = 0; fb < 2; ++fb)
#pragma unroll
                    for (int g2 = 0; g2 < 2; ++g2) {
                        u32x2 ol, oh;
                        ol.x = pack2(acc[fb][tb][8 * g2] * rstd, acc[fb][tb][8 * g2 + 1] * rstd); ol.y = pack2(acc[fb][tb][8 * g2 + 2] * rstd, acc[fb][tb][8 * g2 + 3] * rstd);
                        oh.x = pack2(acc[fb][tb][8 * g2 + 4] * rstd, acc[fb][tb][8 * g2 + 5] * rstd); oh.y = pack2(acc[fb][tb][8 * g2 + 6] * rstd, acc[fb][tb][8 * g2 + 7] * rstd);
                        *(u32x4*)(dst + fb * 32 + 16 * g2 + 8 * h) = pair16(ol, oh);
                    }
            } else {
                u16* dst = VTM + (size_t)(ri.b * 6 + head) * 64 * TALL + ri.tall;
#pragma unroll
                for (int fb = 0; fb < 2; ++fb)
#pragma unroll
                    for (int i = 0; i < 16; ++i) {
                        const int dv = fb * 32 + (i & 3) + 8 * (i >> 2) + 4 * h;
                        dst[(size_t)dv * TALL] = f2bf(acc[fb][tb][i] * rstd);
                    }
            }
        }
    }
}

DI void tokpost_item(const Params& p, int l, int it, char* smem) {
    const int tid = otid(), wave = tid >> 6, lane = tid & 63;
    const u16* U = (const u16*)(p.ws + OFF_U);
    const float* rope = (const float*)(p.ws + OFF_ROPE);
    u16* QG = (u16*)(p.ws + OFF_QG); u16* KG = (u16*)(p.ws + OFF_KG); u16* VTG = (u16*)(p.ws + OFF_VTG); u16* KM = (u16*)(p.ws + OFF_KM);
    u16* sT = (u16*)smem;
    const int row0 = it * 32;
    const int hd = lane >> 3, c = lane & 7;
    const int part = lane & 3, kh = lane >> 2;
    __syncthreads();
    u32x4 raw[8], kr[8], vr[2];
#pragma unroll
    for (int tk = 0; tk < 8; ++tk) {
        const int row = row0 + wave * 8 + tk;
        raw[tk] = *(const u32x4*)(U + (size_t)row * NIN + C_GQ + lane * 8);
        kr[tk] = *(const u32x4*)(U + (size_t)row * NIN + C_KR + part * 8);
    }
#pragma unroll
    for (int i = 0; i < 2; ++i) { const int idx = tid + 256 * i, tok = idx >> 4, ch = idx & 15; vr[i] = *(const u32x4*)(U + (size_t)(row0 + tok) * NIN + C_GV + ch * 8); }
    float w[8];
    { const float* wp = (hd < 6 ? p.gqa_qnw : p.gqa_knw) + l * 64 + c * 8;
      const float4 a = *(const float4*)wp, b = *(const float4*)(wp + 4); w[0] = a.x; w[1] = a.y; w[2] = a.z; w[3] = a.w; w[4] = b.x; w[5] = b.y; w[6] = b.z; w[7] = b.w; }
    const float osc = hd < 6 ? 0.125f * LOG2E : 1.f;
#pragma unroll
    for (int i = 0; i < 2; ++i) { const int idx = tid + 256 * i, tok = idx >> 4, ch = idx & 15; *(u32x4*)(sT + tok * 136 + ch * 8) = vr[i]; }
#pragma unroll
    for (int tk = 0; tk < 8; ++tk) {
        const int row = row0 + wave * 8 + tk;
        const RowInfo ri = rowinfo(row);
        float v[8] = {bflo(raw[tk].x), bfhi(raw[tk].x), bflo(raw[tk].y), bfhi(raw[tk].y), bflo(raw[tk].z), bfhi(raw[tk].z), bflo(raw[tk].w), bfhi(raw[tk].w)};
        float ss = 0.f;
#pragma unroll
        for (int e = 0; e < 8; ++e) ss += v[e] * v[e];
        ss += __shfl_xor(ss, 1); ss += __shfl_xor(ss, 2); ss += __shfl_xor(ss, 4);
        const float rstd = rsqrtf(ss * (1.f / 64.f) + EPS);
#pragma unroll
        for (int e = 0; e < 8; ++e) v[e] = v[e] * rstd * w[e];
        float pr[8];
#pragma unroll
        for (int e = 0; e < 8; ++e) pr[e] = __shfl_xor(v[e], 2);
        if (ri.lat) {
            const int axis = c >> 2, half = (c >> 1) & 1, f0 = (c & 1) * 8, pos = axis ? (ri.t & 63) : (ri.t >> 6);
            const float4 c0 = *(const float4*)(rope + pos * 16 + f0), c1 = *(const float4*)(rope + pos * 16 + f0 + 4);
            const float4 s0 = *(const float4*)(rope + 1024 + pos * 16 + f0), s1 = *(const float4*)(rope + 1024 + pos * 16 + f0 + 4);
            const float cs[8] = {c0.x, c0.y, c0.z, c0.w, c1.x, c1.y, c1.z, c1.w}, sn[8] = {s0.x, s0.y, s0.z, s0.w, s1.x, s1.y, s1.z, s1.w};
#pragma unroll
            for (int e = 0; e < 8; ++e) v[e] = half ? (v[e] * cs[e] + pr[e] * sn[e]) : (v[e] * cs[e] - pr[e] * sn[e]);
        }
        u32x4 o; o.x = pack2(v[0] * osc, v[1] * osc); o.y = pack2(v[2] * osc, v[3] * osc); o.z = pack2(v[4] * osc, v[5] * osc); o.w = pack2(v[6] * osc, v[7] * osc);
        if (hd < 6) *(u32x4*)(QG + ((size_t)(ri.b * 6 + hd) * TALL + ri.tall) * 64 + c * 8) = o;
        else *(u32x4*)(KG + ((size_t)(ri.b * 2 + hd - 6) * TALL + ri.tall) * 64 + c * 8) = o;
        {
            float kv[8] = {bflo(kr[tk].x), bfhi(kr[tk].x), bflo(kr[tk].y), bfhi(kr[tk].y), bflo(kr[tk].z), bfhi(kr[tk].z), bflo(kr[tk].w), bfhi(kr[tk].w)};
            float kp[8];
#pragma unroll
            for (int e = 0; e < 8; ++e) kp[e] = __shfl_xor(kv[e], 1);
            if (ri.lat) {
                const int ax = part >> 1, hf = part & 1, ps = ax ? (ri.t & 63) : (ri.t >> 6);
                const float4 c0 = *(const float4*)(rope + 2048 + ps * 8), c1 = *(const float4*)(rope + 2048 + ps * 8 + 4);
                const float4 s0 = *(const float4*)(rope + 2560 + ps * 8), s1 = *(const float4*)(rope + 2560 + ps * 8 + 4);
                const float cs[8] = {c0.x, c0.y, c0.z, c0.w, c1.x, c1.y, c1.z, c1.w}, sn[8] = {s0.x, s0.y, s0.z, s0.w, s1.x, s1.y, s1.z, s1.w};
#pragma unroll
                for (int e = 0; e < 8; ++e) kv[e] = hf ? (kv[e] * cs[e] + kp[e] * sn[e]) : (kv[e] * cs[e] - kp[e] * sn[e]);
            }
            u32x4 ko; ko.x = pack2(kv[0], kv[1]); ko.y = pack2(kv[2], kv[3]); ko.z = pack2(kv[4], kv[5]); ko.w = pack2(kv[6], kv[7]);
            if (lane < 24) *(u32x4*)(KM + ((size_t)(ri.b * 6 + kh) * TALL + ri.tall) * 96 + 64 + part * 8) = ko;
        }
    }
    __syncthreads();
    {
        const RowInfo r0 = rowinfo(row0);
        const int feat = tid >> 1, hf = tid & 1;
        u32x4 o0, o1;
#pragma unroll
        for (int e = 0; e < 4; ++e) {
            o0[e] = (uint32_t)sT[(hf * 16 + 2 * e) * 136 + feat] | ((uint32_t)sT[(hf * 16 + 2 * e + 1) * 136 + feat] << 16);
            o1[e] = (uint32_t)sT[(hf * 16 + 8 + 2 * e) * 136 + feat] | ((uint32_t)sT[(hf * 16 + 8 + 2 * e + 1) * 136 + feat] << 16);
        }
        u16* dst = VTG + ((size_t)(r0.b * 2 + (feat >> 6)) * 64 + (feat & 63)) * TALL + r0.tall + hf * 16;
        *(u32x4*)dst = o0; *(u32x4*)(dst + 8) = o1;
    }
}

DI int chunk_row0(int b, int g) { return g < 4 ? NLAT + b * 256 + g * 64 : b * 4096 + (g - 4) * 64; }
DI void gla_local_item(const Params& p, int l, int it, char* smem) {
    const int tid = otid();
    const int h = it & 3, g = (it >> 2) % 68, b = it / (4 * 68);
    const int row0 = chunk_row0(b, g);
    const u16* U = (const u16*)(p.ws + OFF_U);
    float* sA = (float*)smem;
    float* sWa = sA + 64 * 33;
    float* sG = sWa + 2 * 16 * 32;
    u16* sV = (u16*)(sG + 2 * 64 * 33);
    float* sLast = (float*)(sV + 64 * 64);
    float* sSeg = sLast + 64;
    const int t = tid >> 2, c0 = (tid & 3) * 8;
    __syncthreads();
    const u32x4 araw = *(const u32x4*)(U + (size_t)(row0 + t) * NIN + C_LA + c0);
    const u32x4 kraw = *(const u32x4*)(U + (size_t)(row0 + t) * NIN + C_LK + h * 32 + c0);
    u32x4 vraw[2];
#pragma unroll
    for (int i = 0; i < 2; ++i) { const int idx = tid + 256 * i, tt = idx >> 3, ch = idx & 7; vraw[i] = *(const u32x4*)(U + (size_t)(row0 + tt) * NIN + C_LV + h * 64 + ch * 8); }
    float wreg[4];
#pragma unroll
    for (int i = 0; i < 4; ++i) { const int idx = tid + 256 * i, d = idx >> 9, rr = (idx >> 5) & 15, c = idx & 31; wreg[i] = (d ? p.wa_b : p.wa_f)[((size_t)l * 16 + rr) * 128 + h * 32 + c]; }
    float bias[2][8];
#pragma unroll
    for (int d = 0; d < 2; ++d) {
        const float* bp = (d ? p.ba_b : p.ba_f) + l * 128 + h * 32 + c0;
        const float4 b0 = *(const float4*)bp, b1 = *(const float4*)(bp + 4);
        bias[d][0] = b0.x; bias[d][1] = b0.y; bias[d][2] = b0.z; bias[d][3] = b0.w; bias[d][4] = b1.x; bias[d][5] = b1.y; bias[d][6] = b1.z; bias[d][7] = b1.w;
    }
    {
        const uint32_t aw[4] = {araw.x, araw.y, araw.z, araw.w};
#pragma unroll
        for (int e = 0; e < 4; ++e) { sA[t * 33 + c0 + 2 * e] = bflo(aw[e]); sA[t * 33 + c0 + 2 * e + 1] = bfhi(aw[e]); }
#pragma unroll
        for (int i = 0; i < 4; ++i) sWa[tid + 256 * i] = wreg[i];
#pragma unroll
        for (int i = 0; i < 2; ++i) { const int idx = tid + 256 * i, tt = idx >> 3, ch = idx & 7; *(u32x4*)(sV + tt * 64 + ch * 8) = vraw[i]; }
    }
    __syncthreads();
#pragma unroll
    for (int d = 0; d < 2; ++d) {
        float a8[8];
#pragma unroll
        for (int e = 0; e < 8; ++e) a8[e] = bias[d][e];
#pragma unroll
        for (int rr = 0; rr < 16; ++rr) {
            const float av = sA[t * 33 + d * 16 + rr];
            const float4 w0 = *(const float4*)(sWa + (d * 16 + rr) * 32 + c0), w1 = *(const float4*)(sWa + (d * 16 + rr) * 32 + c0 + 4);
            a8[0] += av * w0.x; a8[1] += av * w0.y; a8[2] += av * w0.z; a8[3] += av * w0.w; a8[4] += av * w1.x; a8[5] += av * w1.y; a8[6] += av * w1.z; a8[7] += av * w1.w;
        }
#pragma unroll
        for (int e = 0; e < 8; ++e) { const float xv = a8[e]; sG[(d * 64 + t) * 33 + c0 + e] = (fminf(xv, 0.f) - __logf(1.f + __expf(-fabsf(xv)))) * (1.f / 16.f); }
    }
    __syncthreads();
    {
        const int cc = tid & 63, d = cc >> 5, col = cc & 31, seg = tid >> 6;
        float v[16];
#pragma unroll
        for (int i = 0; i < 16; ++i) { const int tok = d ? (seg * 16 + 15 - i) : (seg * 16 + i); v[i] = sG[(d * 64 + tok) * 33 + col]; }
        float run = 0.f;
#pragma unroll
        for (int i = 0; i < 16; ++i) { run += v[i]; v[i] = run; }
        sSeg[seg * 64 + cc] = run;
        __syncthreads();
        float off = 0.f;
#pragma unroll
        for (int sg = 0; sg < 4; ++sg) { const float tv = sSeg[sg * 64 + cc]; off += (d ? (sg > seg) : (sg < seg)) ? tv : 0.f; }
#pragma unroll
        for (int i = 0; i < 16; ++i) { const int tok = d ? (seg * 16 + 15 - i) : (seg * 16 + i); sG[(d * 64 + tok) * 33 + col] = v[i] + off; }
        if (seg == (d ? 0 : 3)) {
            const float lastv = v[15] + off;
            sLast[d * 32 + col] = lastv;
            ((float*)(p.ws + OFF_LAST))[((size_t)((d * NB + b) * 68 + g) * 4 + h) * 32 + col] = lastv;
        }
    }
    __syncthreads();
    {
        float* CUM = (float*)(p.ws + OFF_CUM);
        const uint32_t kw[4] = {kraw.x, kraw.y, kraw.z, kraw.w};
#pragma unroll
        for (int d = 0; d < 2; ++d) {
            float cm[8];
#pragma unroll
            for (int e = 0; e < 8; ++e) cm[e] = sG[(d * 64 + t) * 33 + c0 + e];
            float* cp = CUM + ((size_t)d * TT + row0 + t) * 128 + h * 32 + c0;
            *(float4*)cp = make_float4(cm[0], cm[1], cm[2], cm[3]);
            *(float4*)(cp + 4) = make_float4(cm[4], cm[5], cm[6], cm[7]);
#pragma unroll
            for (int e = 0; e < 4; ++e) {
                sG[(d * 64 + t) * 33 + c0 + 2 * e] = bflo(kw[e]) * __expf(sLast[d * 32 + c0 + 2 * e] - cm[2 * e]);
                sG[(d * 64 + t) * 33 + c0 + 2 * e + 1] = bfhi(kw[e]) * __expf(sLast[d * 32 + c0 + 2 * e + 1] - cm[2 * e + 1]);
            }
        }
    }
    __syncthreads();
    {
        const int dk = tid >> 3, dv0 = (tid & 7) * 8;
        float af[8], ab[8];
#pragma unroll
        for (int e = 0; e < 8; ++e) { af[e] = 0.f; ab[e] = 0.f; }
#pragma unroll 8
        for (int tt = 0; tt < 64; ++tt) {
            const float kf = sG[tt * 33 + dk], kb = sG[(64 + tt) * 33 + dk];
            const u32x4 vv = *(const u32x4*)(sV + tt * 64 + dv0);
            const float v0 = bflo(vv.x), v1 = bfhi(vv.x), v2 = bflo(vv.y), v3 = bfhi(vv.y), v4 = bflo(vv.z), v5 = bfhi(vv.z), v6 = bflo(vv.w), v7 = bfhi(vv.w);
            af[0] += kf * v0; af[1] += kf * v1; af[2] += kf * v2; af[3] += kf * v3; af[4] += kf * v4; af[5] += kf * v5; af[6] += kf * v6; af[7] += kf * v7;
            ab[0] += kb * v0; ab[1] += kb * v1; ab[2] += kb * v2; ab[3] += kb * v3; ab[4] += kb * v4; ab[5] += kb * v5; ab[6] += kb * v6; ab[7] += kb * v7;
        }
        float* df = (float*)(p.ws + OFF_DS) + ((size_t)((0 * NB + b) * 68 + g) * 4 + h) * 2048 + dk * 64 + dv0;
        float* db = (float*)(p.ws + OFF_DS) + ((size_t)((1 * NB + b) * 68 + g) * 4 + h) * 2048 + dk * 64 + dv0;
        *(float4*)df = make_float4(af[0], af[1], af[2], af[3]); *(float4*)(df + 4) = make_float4(af[4], af[5], af[6], af[7]);
        *(float4*)db = make_float4(ab[0], ab[1], ab[2], ab[3]); *(float4*)(db + 4) = make_float4(ab[4], ab[5], ab[6], ab[7]);
    }
}

DI void gla_scan_item(const Params& p, int it) {
    const int tid = otid();
    const int part = it & 3, h = (it >> 2) & 3, b = (it >> 4) & 7, d = it >> 7;
    const float* DS = (const float*)(p.ws + OFF_DS);
    const float* LAST = (const float*)(p.ws + OFF_LAST);
    float* SP = (float*)(p.ws + OFF_SPREV);
    const int e0 = part * 512 + tid * 2, dk = e0 >> 6;
    const size_t base = (size_t)((d * NB + b) * 68) * 4 + h;
    float s0 = 0.f, s1 = 0.f;
#pragma unroll 17
    for (int st = 0; st < 68; ++st) {
        const int g = d == 0 ? st : (st < 4 ? 3 - st : 71 - st);
        const size_t ix = base + (size_t)g * 4;
        const float e = __expf(LAST[ix * 32 + dk]);
        const float2 dv = *(const float2*)(DS + ix * 2048 + e0);
        *(float2*)(SP + ix * 2048 + e0) = make_float2(s0, s1);
        s0 = s0 * e + dv.x; s1 = s1 * e + dv.y;
    }
}

DI void gla_out_item(const Params& p, int l, int b, int h, int g, char* smem) {
    const int tid = otid(), wave = tid >> 6, lane = tid & 63, r = lane & 31, hh = lane >> 5, qb = wave & 1, db = wave >> 1;
    const int row0 = chunk_row0(b, g);
    u16* U = (u16*)(p.ws + OFF_U);
    const float* CUM = (const float*)(p.ws + OFF_CUM);
    u16* sS = (u16*)smem;
    u16* sQ = sS + 64 * 40;
    u16* sK = sQ + 64 * 40;
    u16* sVt = sK + 64 * 40;
    float* sRed = (float*)(sVt + 64 * 72);
    const int dk = tid >> 3, dv0 = (tid & 7) * 8;
    float Sf[8], Sb[8];
    {
        const float* SP = (const float*)(p.ws + OFF_SPREV);
        const float* pf = SP + ((size_t)((0 * NB + b) * 68 + g) * 4 + h) * 2048 + dk * 64 + dv0;
        const float* pb = SP + ((size_t)((1 * NB + b) * 68 + g) * 4 + h) * 2048 + dk * 64 + dv0;
        const float4 a0 = *(const float4*)pf, a1 = *(const float4*)(pf + 4), b0 = *(const float4*)pb, b1 = *(const float4*)(pb + 4);
        Sf[0] = a0.x; Sf[1] = a0.y; Sf[2] = a0.z; Sf[3] = a0.w; Sf[4] = a1.x; Sf[5] = a1.y; Sf[6] = a1.z; Sf[7] = a1.w;
        Sb[0] = b0.x; Sb[1] = b0.y; Sb[2] = b0.z; Sb[3] = b0.w; Sb[4] = b1.x; Sb[5] = b1.y; Sb[6] = b1.z; Sb[7] = b1.w;
    }
    f32x16 o;
#pragma unroll
    for (int i = 0; i < 16; ++i) o[i] = 0.f;
    const int t_ = tid >> 2, c0_ = (tid & 3) * 8, d0_ = (tid & 3) * 16;
    const u32x4 v0 = *(const u32x4*)(U + (size_t)(row0 + t_) * NIN + C_LV + h * 64 + d0_), v1 = *(const u32x4*)(U + (size_t)(row0 + t_) * NIN + C_LV + h * 64 + d0_ + 8);
    const u32x4 qv = *(const u32x4*)(U + (size_t)(row0 + t_) * NIN + C_LQ + h * 32 + c0_), kv = *(const u32x4*)(U + (size_t)(row0 + t_) * NIN + C_LK + h * 32 + c0_);
    float4 cma[2], cmb[2];
#pragma unroll
    for (int d = 0; d < 2; ++d) { const float* cp = CUM + ((size_t)d * TT + row0 + t_) * 128 + h * 32 + c0_; cma[d] = *(const float4*)cp; cmb[d] = *(const float4*)(cp + 4); }
    __syncthreads();
    {
        const int t = t_, d0 = d0_;
        const uint32_t w[8] = {v0.x, v0.y, v0.z, v0.w, v1.x, v1.y, v1.z, v1.w};
#pragma unroll
        for (int e = 0; e < 8; ++e) { sVt[(d0 + 2 * e) * 72 + t] = (u16)(w[e] & 0xffffu); sVt[(d0 + 2 * e + 1) * 72 + t] = (u16)(w[e] >> 16); }
    }
#pragma unroll
    for (int d = 0; d < 2; ++d) {
        if (d) __syncthreads();
        {
#pragma unroll
            for (int e = 0; e < 8; ++e) sS[(dv0 + e) * 40 + dk] = f2bf(d ? Sb[e] : Sf[e]);
            const int t = t_, c0 = c0_;
            const float4 ca = cma[d], cb = cmb[d];
            const float cm[8] = {ca.x, ca.y, ca.z, ca.w, cb.x, cb.y, cb.z, cb.w};
            const uint32_t qw[4] = {qv.x, qv.y, qv.z, qv.w}, kw[4] = {kv.x, kv.y, kv.z, kv.w};
            u32x4 qo, ko;
#pragma unroll
            for (int e = 0; e < 4; ++e) {
                const float e0 = __expf(cm[2 * e]), e1 = __expf(cm[2 * e + 1]);
                qo[e] = pack2(bflo(qw[e]) * e0 * 0.17677669529663687f, bfhi(qw[e]) * e1 * 0.17677669529663687f);
                ko[e] = pack2(bflo(kw[e]) / e0, bfhi(kw[e]) / e1);
            }
            *(u32x4*)(sQ + t * 40 + c0) = qo;
            *(u32x4*)(sK + t * 40 + c0) = ko;
        }
        __syncthreads();
        bf16x8 qf[2];
#pragma unroll
        for (int ks = 0; ks < 2; ++ks) qf[ks] = *(const bf16x8*)(sQ + (qb * 32 + r) * 40 + ks * 16 + hh * 8);
        const int pr = (r & 0x13) | ((r & 4) << 1) | ((r & 8) >> 1);
#pragma unroll
        for (int kb = 0; kb < 2; ++kb) {
            if (d == 0 ? (kb > qb) : (kb < qb)) continue;
            f32x16 s;
#pragma unroll
            for (int i = 0; i < 16; ++i) s[i] = 0.f;
#pragma unroll
            for (int ks = 0; ks < 2; ++ks) s = MFMA(*(const bf16x8*)(sK + (kb * 32 + pr) * 40 + ks * 16 + hh * 8), qf[ks], s);
            const int iq = qb * 32 + r;
#pragma unroll
            for (int i = 0; i < 16; ++i) {
                const int jk = kb * 32 + 16 * (i >> 3) + 8 * hh + (i & 7);
                const bool keep = d == 0 ? (jk <= iq) : (jk >= iq);
                s[i] = keep ? s[i] : 0.f;
            }
#pragma unroll
            for (int sp = 0; sp < 2; ++sp) {
                u32x4 pk; pk.x = pack2(s[8 * sp], s[8 * sp + 1]); pk.y = pack2(s[8 * sp + 2], s[8 * sp + 3]); pk.z = pack2(s[8 * sp + 4], s[8 * sp + 5]); pk.w = pack2(s[8 * sp + 6], s[8 * sp + 7]);
                o = MFMA(*(const bf16x8*)(sVt + (db * 32 + r) * 72 + kb * 32 + 16 * sp + 8 * hh), __builtin_bit_cast(bf16x8, pk), o);
            }
        }
#pragma unroll
        for (int ks = 0; ks < 2; ++ks) o = MFMA(*(const bf16x8*)(sS + (db * 32 + r) * 40 + ks * 16 + hh * 8), qf[ks], o);
    }
    float ss = 0.f;
#pragma unroll
    for (int i = 0; i < 16; ++i) ss += o[i] * o[i];
    ss += __shfl_xor(ss, 32);
    if (hh == 0) sRed[db * 64 + qb * 32 + r] = ss;
    __syncthreads();
    const float rstd = rsqrtf((sRed[qb * 32 + r] + sRed[64 + qb * 32 + r]) * (1.f / 64.f) + EPS);
    u16* zp = U + (size_t)(row0 + qb * 32 + r) * NIN + C_Z + h * 64 + db * 32 + 4 * hh;
    const float* nw = p.gla_nw + l * 64 + db * 32 + 4 * hh;
#pragma unroll
    for (int g4 = 0; g4 < 4; ++g4) {
        const u32x2 zz = *(const u32x2*)(zp + 8 * g4);
        const float4 w4 = *(const float4*)(nw + 8 * g4);
        u32x2 y;
        y.x = pack2(o[4 * g4] * rstd * w4.x * silu(bflo(zz.x)), o[4 * g4 + 1] * rstd * w4.y * silu(bfhi(zz.x)));
        y.y = pack2(o[4 * g4 + 2] * rstd * w4.z * silu(bflo(zz.y)), o[4 * g4 + 3] * rstd * w4.w * silu(bfhi(zz.y)));
        *(u32x2*)(zp + 8 * g4) = y;
    }
}

template <int DQK>
DI void attn_item(const u16* __restrict__ Q, const u16* __restrict__ K, const u16* __restrict__ Vt, int nkeys, int q0, u16* yz  , char* smem) {
    constexpr int KST = DQK + 8, NKS = DQK / 16, CPR = DQK / 8, NKC = 64 * CPR / 256, STG = 64 * KST + 64 * 72;
    const int tid = otid(), wave = tid >> 6, lane = tid & 63, r = lane & 31, h = lane >> 5;
    u16* sbase = (u16*)smem;
    bf16x8 qf[NKS];
#pragma unroll
    for (int ks = 0; ks < NKS; ++ks) qf[ks] = *(const bf16x8*)(Q + (size_t)(q0 + wave * 32 + r) * DQK + ks * 16 + h * 8);
    f32x16 o[2];
#pragma unroll
    for (int i = 0; i < 16; ++i) { o[0][i] = 0.f; o[1][i] = 0.f; }
    float mref = 0.f, lsum = 0.f;
    f32x16 negm;
#pragma unroll
    for (int i = 0; i < 16; ++i) negm[i] = 0.f;
    u32x4 rk[NKC], rv[2];
    const int ntiles = nkeys >> 6;
#pragma unroll
    for (int i = 0; i < NKC; ++i) { const int c = tid + 256 * i, row = c / CPR, ch = c % CPR; rk[i] = *(const u32x4*)(K + (size_t)row * DQK + ch * 8); }
#pragma unroll
    for (int i = 0; i < 2; ++i) { const int c = tid + 256 * i, row = c >> 3, ch = c & 7; rv[i] = *(const u32x4*)(Vt + (size_t)row * TALL + ch * 8); }
#pragma unroll
    for (int i = 0; i < NKC; ++i) { const int c = tid + 256 * i, row = c / CPR, ch = c % CPR; *(u32x4*)(sbase + row * KST + ch * 8) = rk[i]; }
#pragma unroll
    for (int i = 0; i < 2; ++i) { const int c = tid + 256 * i, row = c >> 3, ch = c & 7; *(u32x4*)(sbase + 64 * KST + row * 72 + ch * 8) = rv[i]; }
#pragma unroll
    for (int i = 0; i < NKC; ++i) { const int c = tid + 256 * i, row = c / CPR, ch = c % CPR; rk[i] = *(const u32x4*)(K + (size_t)(64 + row) * DQK + ch * 8); }
#pragma unroll
    for (int i = 0; i < 2; ++i) { const int c = tid + 256 * i, row = c >> 3, ch = c & 7; rv[i] = *(const u32x4*)(Vt + (size_t)row * TALL + 64 + ch * 8); }
    __syncthreads();
    const int pr = (r & 0x13) | ((r & 4) << 1) | ((r & 8) >> 1);
    for (int kt = 0; kt < ntiles; ++kt) {
        const u16* sK = sbase + (kt & 1) * STG;
        const u16* sVt = sK + 64 * KST;
        f32x16 s[2];
        {
            bf16x8 kf0[NKS], kf1[NKS];
#pragma unroll
            for (int ks = 0; ks < NKS; ++ks) kf0[ks] = *(const bf16x8*)(sK + pr * KST + ks * 16 + h * 8);
            mfence();
#pragma unroll
            for (int ks = 0; ks < NKS; ++ks) kf1[ks] = *(const bf16x8*)(sK + (32 + pr) * KST + ks * 16 + h * 8);
            mfence();
            if (kt + 1 < ntiles) {
                u16* dK = sbase + ((kt + 1) & 1) * STG;
#pragma unroll
                for (int i = 0; i < NKC; ++i) { const int c = tid + 256 * i, row = c / CPR, ch = c % CPR; *(u32x4*)(dK + row * KST + ch * 8) = rk[i]; }
#pragma unroll
                for (int i = 0; i < 2; ++i) { const int c = tid + 256 * i, row = c >> 3, ch = c & 7; *(u32x4*)(dK + 64 * KST + row * 72 + ch * 8) = rv[i]; }
                if (kt + 2 < ntiles) {
                    const int key0 = (kt + 2) * 64;
#pragma unroll
                    for (int i = 0; i < NKC; ++i) { const int c = tid + 256 * i, row = c / CPR, ch = c % CPR; rk[i] = *(const u32x4*)(K + (size_t)(key0 + row) * DQK + ch * 8); }
#pragma unroll
                    for (int i = 0; i < 2; ++i) { const int c = tid + 256 * i, row = c >> 3, ch = c & 7; rv[i] = *(const u32x4*)(Vt + (size_t)row * TALL + key0 + ch * 8); }
                }
            }
            mfence();
            s[0] = MFMA(kf0[0], qf[0], negm);
            s[1] = MFMA(kf1[0], qf[0], negm);
#pragma unroll
            for (int ks = 1; ks < NKS; ++ks) { s[0] = MFMA(kf0[ks], qf[ks], s[0]); s[1] = MFMA(kf1[ks], qf[ks], s[1]); }
        }
        bf16x8 vf[2][4];
#pragma unroll
        for (int db = 0; db < 2; ++db)
#pragma unroll
            for (int q = 0; q < 4; ++q) vf[db][q] = *(const bf16x8*)(sVt + (db * 32 + r) * 72 + q * 16 + 8 * h);
        mfence();
        float mx = fmaxf(s[0][0], s[1][0]);
#pragma unroll
        for (int i = 1; i < 16; ++i) mx = max3f(mx, s[0][i], s[1][i]);
        mx = xhalf_max(mx);
        const bool need = (kt == 0) || (mx > 8.f);
        if (__builtin_amdgcn_ballot_w64(need) != 0ull) {
            const float delta = need ? mx : 0.f, alpha = __builtin_amdgcn_exp2f(-delta);
            mref += delta; lsum *= alpha;
#pragma unroll
            for (int i = 0; i < 16; ++i) { o[0][i] *= alpha; o[1][i] *= alpha; s[0][i] -= delta; s[1][i] -= delta; negm[i] = -mref; }
        }
        float ps = 0.f;
#pragma unroll
        for (int kb = 0; kb < 2; ++kb)
#pragma unroll
            for (int i = 0; i < 16; ++i) { const float pv = __builtin_amdgcn_exp2f(s[kb][i]); s[kb][i] = pv; ps += pv; }
        lsum += ps;
#pragma unroll
        for (int kb = 0; kb < 2; ++kb)
#pragma unroll
            for (int sp = 0; sp < 2; ++sp) {
                u32x4 pk; pk.x = pack2(s[kb][8 * sp], s[kb][8 * sp + 1]); pk.y = pack2(s[kb][8 * sp + 2], s[kb][8 * sp + 3]);
                pk.z = pack2(s[kb][8 * sp + 4], s[kb][8 * sp + 5]); pk.w = pack2(s[kb][8 * sp + 6], s[kb][8 * sp + 7]);
                const bf16x8 pb = __builtin_bit_cast(bf16x8, pk);
#pragma unroll
                for (int db = 0; db < 2; ++db) o[db] = MFMA(vf[db][kb * 2 + sp], pb, o[db]);
            }
        __syncthreads();
    }
    lsum = xhalf_sum(lsum);
    const float inv = 1.f / lsum;
    float* sF = (float*)smem;
#pragma unroll
    for (int db = 0; db < 2; ++db)
#pragma unroll
        for (int g4 = 0; g4 < 4; ++g4)
            *(float4*)(sF + (wave * 32 + r) * 68 + db * 32 + 8 * g4 + 4 * h) = make_float4(o[db][4 * g4] * inv, o[db][4 * g4 + 1] * inv, o[db][4 * g4 + 2] * inv, o[db][4 * g4 + 3] * inv);
    __syncthreads();
#pragma unroll
    for (int i = 0; i < 4; ++i) {
        const int idx = tid + 256 * i, row = idx >> 3, ch = idx & 7;
        u16* zq = yz + (size_t)row * NIN + ch * 8;
        const u32x4 zz = *(const u32x4*)zq;
        const float4 a = *(const float4*)(sF + row * 68 + ch * 8), b = *(const float4*)(sF + row * 68 + ch * 8 + 4);
        u32x4 y;
        y.x = pack2(a.x * silu(bflo(zz.x)), a.y * silu(bfhi(zz.x))); y.y = pack2(a.z * silu(bflo(zz.y)), a.w * silu(bfhi(zz.y)));
        y.z = pack2(b.x * silu(bflo(zz.z)), b.y * silu(bfhi(zz.z))); y.w = pack2(b.z * silu(bflo(zz.w)), b.w * silu(bfhi(zz.w)));
        *(u32x4*)zq = y;
    }
}

DI void attn_dispatch(const Params& p, int pair, int qt, int is_ctx, char* smem) {
    const int b = pair / 12, hd = pair % 12;
    const int q0 = is_ctx ? qt * 128 : 256 + qt * 128, nkeys = is_ctx ? 256 : TALL;
    const int row0 = is_ctx ? NLAT + b * 256 + qt * 128 : b * 4096 + qt * 128;
    u16* U = (u16*)(p.ws + OFF_U);
    if (hd < 6) {
        const size_t bh = (size_t)(b * 6 + hd);
        attn_item<96>((const u16*)(p.ws + OFF_QM) + bh * TALL * 96, (const u16*)(p.ws + OFF_KM) + bh * TALL * 96, (const u16*)(p.ws + OFF_VTM) + bh * 64 * TALL, nkeys, q0,
                      U + (size_t)row0 * NIN + C_Z + 256 + hd * 64, smem);
    } else {
        const int hq = hd - 6, kvh = hq / 3;
        attn_item<64>((const u16*)(p.ws + OFF_QG) + (size_t)(b * 6 + hq) * TALL * 64, (const u16*)(p.ws + OFF_KG) + (size_t)(b * 2 + kvh) * TALL * 64,
                      (const u16*)(p.ws + OFF_VTG) + (size_t)(b * 2 + kvh) * 64 * TALL, nkeys, q0, U + (size_t)row0 * NIN + C_Z + 640 + hq * 64, smem);
    }
}

DI void outproj_tile(const Params& p, int l, int mt, int nt, char* smem) {
    const int tid = otid(), wave = tid >> 6, lane = tid & 63, r = lane & 31, h = lane >> 5, wf = wave & 1, wt = wave >> 1;
    u16* sW = (u16*)smem;
    f32x16 acc[2][4]; zero_acc(acc);
    gemm_core((const u16*)(p.ws + OFF_WOUT) + ((size_t)l * 1024 + nt * 128) * 1024, 1024, (const u16*)(p.ws + OFF_U) + (size_t)mt * TM * NIN + C_Z, NIN, 1024, sW, acc);
    const int j = mt < 128 ? (mt >> 4) : 8;
    const float* MOD = (const float*)(p.ws + OFF_MOD);
    float* sF = (float*)smem;
    const int c4 = (tid & 31) * 4, n = nt * 128 + c4;
    const float4 gv = *(const float4*)(MOD + (size_t)(l * 9 + j) * 3072 + 2048 + n);
    float4 gn = make_float4(0.f, 0.f, 0.f, 0.f);
    if (l < DEPTH - 1) {
        const float4 sv = *(const float4*)(MOD + (size_t)((l + 1) * 9 + j) * 3072 + 1024 + n), wv = *(const float4*)(p.norm_w + (l + 1) * 1024 + n);
        gn = make_float4(wv.x * (1.f + sv.x), wv.y * (1.f + sv.y), wv.z * (1.f + sv.z), wv.w * (1.f + sv.w));
    }
#pragma unroll
    for (int half = 0; half < 2; ++half) {
        __syncthreads();
        if (wt == half) {
#pragma unroll
            for (int tb = 0; tb < 4; ++tb)
#pragma unroll
                for (int fb = 0; fb < 2; ++fb)
#pragma unroll
                    for (int g4 = 0; g4 < 4; ++g4)
                        *(float4*)(sF + (tb * 32 + r) * 132 + wf * 64 + fb * 32 + 8 * g4 + 4 * h) =
                            make_float4(acc[fb][tb][4 * g4], acc[fb][tb][4 * g4 + 1], acc[fb][tb][4 * g4 + 2], acc[fb][tb][4 * g4 + 3]);
        }
        __syncthreads();
        float4 xin[16];
#pragma unroll
        for (int i = 0; i < 16; ++i) {
            const int row = mt * TM + half * 128 + (tid >> 5) + 8 * i;
            const bool lat = row < NLAT;
            const float* xo = l == 0 ? (lat ? p.x + (size_t)row * 1024 : p.ctx + (size_t)(row - NLAT) * 1024)
                                     : (lat ? p.out + (size_t)row * 1024 : (const float*)(p.ws + OFF_CTXX) + (size_t)(row - NLAT) * 1024);
            xin[i] = *(const float4*)(xo + n);
        }
#pragma unroll
        for (int i = 0; i < 16; ++i) {
            const int rr = (tid >> 5) + 8 * i, row = mt * TM + half * 128 + rr;
            const bool lat = row < NLAT;
            float* xn = lat ? p.out + (size_t)row * 1024 : (float*)(p.ws + OFF_CTXX) + (size_t)(row - NLAT) * 1024;
            const float4 xv = xin[i], av = *(const float4*)(sF + rr * 132 + c4);
            float4 nv;
            nv.x = xv.x + gv.x * av.x; nv.y = xv.y + gv.y * av.y; nv.z = xv.z + gv.z * av.z; nv.w = xv.w + gv.w * av.w;
            *(float4*)(xn + n) = nv;
            if (l < DEPTH - 1) {
                u32x2 o; o.x = pack2(nv.x * gn.x, nv.y * gn.y); o.y = pack2(nv.z * gn.z, nv.w * gn.w);
                *(u32x2*)((u16*)(p.ws + OFF_XG) + (size_t)row * 1024 + n) = o;
            }
            float ss = nv.x * nv.x + nv.y * nv.y + nv.z * nv.z + nv.w * nv.w;
            ss += __shfl_xor(ss, 1); ss += __shfl_xor(ss, 2); ss += __shfl_xor(ss, 4); ss += __shfl_xor(ss, 8); ss += __shfl_xor(ss, 16);
            if ((tid & 31) < 2) ((float*)(p.ws + OFF_RSS))[(size_t)row * 16 + nt * 2 + (tid & 31)] = (tid & 31) == 0 ? ss : 0.f;
        }
    }
}

DI void final_phase(const Params& p) {
    const int tid = otid(), wave = tid >> 6, lane = tid & 63;
    const float* RSS = (const float*)(p.ws + OFF_RSS);
    float4 w[4];
#pragma unroll
    for (int i = 0; i < 4; ++i) w[i] = *(const float4*)(p.final_nw + lane * 4 + 256 * i);
    for (int it = blockIdx.x; it < NLAT / 32; it += gridDim.x) {
        for (int rr = 0; rr < 8; ++rr) {
            const int row = it * 32 + wave * 8 + rr;
            float s = 0.f;
#pragma unroll
            for (int q = 0; q < 4; ++q) { const float4 v = *(const float4*)(RSS + (size_t)row * 16 + 4 * q); s += (v.x + v.y) + (v.z + v.w); }
            const float rstd = rsqrtf(s * (1.f / 1024.f) + EPS);
#pragma unroll
            for (int i = 0; i < 4; ++i) {
                float4* ptr = (float4*)(p.out + (size_t)row * 1024 + lane * 4 + 256 * i);
                float4 v = *ptr;
                v.x = v.x * rstd * w[i].x; v.y = v.y * rstd * w[i].y; v.z = v.z * rstd * w[i].z; v.w = v.w * rstd * w[i].w;
                *ptr = v;
            }
        }
    }
}


#define XB_TMO      128
#define XB_XCNT(j)  (256  + 64 * (j))
#define XB_XSUB(j)  (1280 + 64 * (j))
#define XB_XGEN(j)  (2304 + 64 * (j))
#define XB_TOP      3328
#define XB_TOPGEN   3392
#define XB_SPIN_CAP (1u << 22)
#define LAS __attribute__((address_space(3)))
DI unsigned xb_ld(unsigned* p) { return __hip_atomic_load(p, __ATOMIC_RELAXED, __HIP_MEMORY_SCOPE_AGENT); }
DI unsigned xb_add(unsigned* p, unsigned v) { return __hip_atomic_fetch_add(p, v, __ATOMIC_RELAXED, __HIP_MEMORY_SCOPE_AGENT); }
DI unsigned xb_xcc_id() { return (unsigned)__builtin_amdgcn_s_getreg((3 << 11) | 20) & 0xFu; }
#define XB_SPIN(cond, bar) do { unsigned _sp = 0; while (cond) { __builtin_amdgcn_s_sleep(0); \
    if ((++_sp & 255u) == 0u) { if (xb_ld(&(bar)[XB_TMO])) break; if (_sp > XB_SPIN_CAP) { atomicAdd(&(bar)[XB_TMO], 1u); break; } } } } while (0)
struct XcdBarrier { unsigned* bar; unsigned x; volatile LAS unsigned* st; };
DI XcdBarrier xcd_barrier_post(unsigned* bar, volatile LAS unsigned* st) {
    XcdBarrier b; b.bar = bar; b.x = xb_xcc_id(); b.st = st;
    if (threadIdx.x == 0) (void)xb_add(&bar[XB_XCNT(b.x)], 1u);
    return b;
}
DI void xcd_barrier_complete(unsigned* bar, unsigned x, unsigned& nloc, unsigned& nx) {
    const unsigned G = gridDim.x * gridDim.y * gridDim.z;
    unsigned sum, cnt, mine, sp = 0u;
    for (;;) {
        sum = 0u; cnt = 0u; mine = 0u;
#pragma unroll
        for (unsigned j = 0; j < 16; ++j) { const unsigned c = xb_ld(&bar[XB_XCNT(j)]); sum += c; cnt += (c > 0u) ? 1u : 0u; mine = (j == x) ? c : mine; }
        if (sum == G) break;
        __builtin_amdgcn_s_sleep(1);
        if ((++sp & 255u) == 0u) { if (xb_ld(&bar[XB_TMO])) break; if (sp > XB_SPIN_CAP) { atomicAdd(&bar[XB_TMO], 1u); break; } }
    }
    nloc = mine > 0u ? mine : 1u; nx = cnt > 0u ? cnt : 1u;
}
DI void xcd_barrier(const XcdBarrier& b) {
    asm volatile("s_waitcnt vmcnt(0)" ::: "memory");
    __syncthreads();
    if (threadIdx.x == 0) {
        unsigned* bar = b.bar;
        __builtin_amdgcn_s_waitcnt(0);
        unsigned nloc = b.st[0], nx = b.st[1];
        if (nloc == 0u) { xcd_barrier_complete(bar, b.x, nloc, nx); b.st[0] = nloc; b.st[1] = nx; }
        const unsigned old = xb_add(&bar[XB_XSUB(b.x)], 1u);
        const unsigned gen = old / nloc;
        if (old + 1u == (gen + 1u) * nloc) {
            __builtin_amdgcn_fence(__ATOMIC_RELEASE, "agent");
            asm volatile("s_waitcnt vmcnt(0)" ::: "memory");
            const unsigned og = xb_add(&bar[XB_TOP], 1u);
            const unsigned tg = og / nx;
            if (og + 1u == (tg + 1u) * nx) xb_add(&bar[XB_TOPGEN], 1u);
            else XB_SPIN(xb_ld(&bar[XB_TOPGEN]) == tg, bar);
            __builtin_amdgcn_fence(__ATOMIC_ACQUIRE, "agent");
            xb_add(&bar[XB_XGEN(b.x)], 1u);
            asm volatile("s_waitcnt vmcnt(0)" ::: "memory");
        } else {
            XB_SPIN(xb_ld(&bar[XB_XGEN(b.x)]) == gen, bar);
            __builtin_amdgcn_fence(__ATOMIC_ACQUIRE, "agent");
            asm volatile("s_waitcnt vmcnt(0)" ::: "memory");
        }
    }
    __syncthreads();
}


DI int fetch_item(unsigned* ctr, int* s_slot) {
    __syncthreads();
    if (threadIdx.x == 0) *s_slot = (int)__hip_atomic_fetch_add(ctr, 1u, __ATOMIC_RELAXED, __HIP_MEMORY_SCOPE_AGENT);
    __syncthreads();
    return *s_slot;
}
DI void run_phase(const Params& p, int ph, char* smem, int* s_slot) {
    unsigned* ctr = (unsigned*)(p.ws + OFF_BAR) + 3456 + 64 * ph;
    if (ph == 0) { phase0(p, smem); return; }
    if (ph == 1) { phase1(p, smem); return; }
    if (ph == NPHASE - 1) { final_phase(p); return; }
    const int l = (ph - 2) / 5, sub = (ph - 2) % 5;
    const bool want_ctx = l < DEPTH - 1;
    if (sub == 0) {
        const int xcd = blockIdx.x & 7, nbx = gridDim.x >> 3;
        for (int q = blockIdx.x >> 3; q < 17 * 22; q += nbx) {
            int mtl, nt;
            if (q < 352) { const int g = q / 176, rr = q % 176; if (rr < 128) { nt = (rr >> 6) * 8 + (rr & 7); mtl = g * 8 + ((rr & 63) >> 3); } else { const int r48 = rr - 128; nt = 16 + r48 % 6; mtl = g * 8 + r48 / 6; } }
            else { nt = q - 352; mtl = 16; }
            inproj_tile(p, l, xcd * 17 + mtl, nt, smem);
        }
    } else if (sub == 1) {
        constexpr int N_UP = 136 * 11, N_GL = NB * 68 * 4, N_TP = TT / 32;
        const int xcd = blockIdx.x & 7, nbx = gridDim.x >> 3;
        for (int q = blockIdx.x >> 3; q < 17 * 11; q += nbx) upproj_tile(p, l, xcd * 17 + q / 11, q % 11, smem);
        for (;;) {
            const int it = fetch_item(ctr, s_slot);
            if (it >= N_GL + N_TP) break;
            if (it < N_GL) gla_local_item(p, l, it, smem);
            else tokpost_item(p, l, it - N_GL, smem);
        }
    } else if (sub == 2) {
        for (int it = blockIdx.x; it < 256; it += gridDim.x) gla_scan_item(p, it);
    } else if (sub == 3) {
        const int n_lat = 3072, n_ctx = want_ctx ? 192 : 0, ng = want_ctx ? 68 : 64, n_gla = NB * 4 * ng;
        if ((gridDim.x >> 3) == 64) {
            const int xcd = blockIdx.x & 7, j = blockIdx.x >> 3, half = j >> 5, qt = j & 31;
            for (int k = 0; k < 6; ++k) {
                const int kk = (k + xcd) % 6, m = kk >> 1;
                const int hd = (kk & 1) ? 6 + half * 3 + m : half * 3 + m;
                __syncthreads();
                attn_dispatch(p, xcd * 12 + hd, qt, 0, smem);
            }
        } else
        for (int it = blockIdx.x; it < n_lat; it += gridDim.x) {
            __syncthreads();
            const int pair = (it >> 8) * 8 + (it & 7), qt = (it >> 3) & 31;
            attn_dispatch(p, pair, qt, 0, smem);
        }
        for (;;) {
            const int it = fetch_item(ctr, s_slot);
            if (it >= n_ctx + n_gla) break;
            if (it < n_ctx) attn_dispatch(p, it >> 1, it & 1, 1, smem);
            else {
                const int i3 = it - n_ctx;
                const int g = (i3 % ng) + (want_ctx ? 0 : 4), h = (i3 / ng) & 3, b = i3 / (ng * 4);
                gla_out_item(p, l, b, h, g, smem);
            }
        }
    } else {
        const int mpx = want_ctx ? 17 : 16, xcd = blockIdx.x & 7, nbx = gridDim.x >> 3;
        for (int q = blockIdx.x >> 3; q < mpx * 8; q += nbx) outproj_tile(p, l, xcd * mpx + (q >> 3), q & 7, smem);
        if (l + 1 < DEPTH) for (;;) {
            const int it = fetch_item(ctr, s_slot);
            if (it >= 44 + N_WCONV) break;
            if (it < 44) bias_item(p, l + 1, it, smem);
            else wconv_item(p, l + 1, it - 44, (float*)smem);
        }
    }
}

__global__ void __launch_bounds__(256, 2) mega_kernel(Params p) {
    __shared__ __attribute__((aligned(16))) char smem[73728];
    __shared__ u32x4 xb_words;
    __shared__ int s_slot;
    if (p.phase_end < 0) cg::this_grid().sync();
    if (threadIdx.x == 0) xb_words = (u32x4){0u, 0u, 0u, 0u};
    __syncthreads();
    const XcdBarrier xb = xcd_barrier_post((unsigned*)(p.ws + OFF_BAR), (volatile LAS unsigned*)&xb_words);
    for (int ph = p.phase_begin; ph < p.phase_end; ++ph) {
        run_phase(p, ph, smem, &s_slot);
        if (ph + 1 < p.phase_end) xcd_barrier(xb);
    }
}

extern "C" void kernel_launch(void* const* d_in, const int* in_sizes, int n_in, void* d_out, int out_size, void* d_ws, size_t ws_size, hipStream_t stream) {
    (void)in_sizes; (void)n_in; (void)out_size;
    if (ws_size < WS_TOTAL) { fprintf(stderr, "workspace too small: %zu < %zu\n", ws_size, (size_t)WS_TOTAL); return; }
    Params p{};
    p.x = (const float*)d_in[0]; p.c = (const float*)d_in[1]; p.ctx = (const float*)d_in[2]; p.c_ctx = (const float*)d_in[3]; p.norm_w = (const float*)d_in[4];
    p.w_mod = (const float*)d_in[5]; p.b_mod = (const float*)d_in[6]; p.w_in = (const float*)d_in[7]; p.wa_f = (const float*)d_in[8]; p.ba_f = (const float*)d_in[9];
    p.wa_b = (const float*)d_in[10]; p.ba_b = (const float*)d_in[11]; p.gla_nw = (const float*)d_in[12]; p.mla_qnw = (const float*)d_in[13]; p.w_uq = (const float*)d_in[14];
    p.mla_kvnw = (const float*)d_in[15]; p.w_ukv = (const float*)d_in[16]; p.gqa_qnw = (const float*)d_in[17]; p.gqa_knw = (const float*)d_in[18]; p.w_out = (const float*)d_in[19];
    p.final_nw = (const float*)d_in[20];
    p.out = (float*)d_out; p.ws = (char*)d_ws;
    static int grid_blocks = 0;
    if (!grid_blocks) {
        int dev = 0, cus = 0, per_cu = 0;
        hipGetDevice(&dev);
        hipDeviceGetAttribute(&cus, hipDeviceAttributeMultiprocessorCount, dev);
        hipOccupancyMaxActiveBlocksPerMultiprocessor(&per_cu, mega_kernel, 256, 0);
        if (per_cu < 1) per_cu = 1;
        if (per_cu > 2) per_cu = 2;
        grid_blocks = (cus * per_cu) & ~7;
    }
#if MK_MODE == 1
    p.phase_begin = 0; p.phase_end = NPHASE;
    hipMemsetAsync((char*)d_ws + OFF_BAR, 0, SZ_BAR, stream);
    void* args[] = {&p};
    hipError_t e = hipLaunchCooperativeKernel((void*)mega_kernel, dim3(grid_blocks), dim3(256), args, 0, stream);
    if (e != hipSuccess) fprintf(stderr, "cooperative launch failed: %s (grid %d)\n", hipGetErrorString(e), grid_blocks);
#else
    for (int ph = 0; ph < NPHASE; ++ph) {
        p.phase_begin = ph; p.phase_end = ph + 1;
        hipLaunchKernelGGL(mega_kernel, dim3(grid_blocks), dim3(256), 0, stream, p);
    }
#endif
}
```

```cpp
#include <hip/hip_runtime.h>
#include <hip/hip_cooperative_groups.h>
#include <stdint.h>
#include <cstdio>
namespace cg = cooperative_groups;

#ifndef MK_MODE
#define MK_MODE 1
#endif

typedef unsigned short u16;
typedef short bf16x8 __attribute__((ext_vector_type(8)));
typedef float f32x16 __attribute__((ext_vector_type(16)));
typedef __bf16 bf2_t __attribute__((ext_vector_type(2)));
typedef float f2_t __attribute__((ext_vector_type(2)));
typedef uint32_t u32x4 __attribute__((ext_vector_type(4)));
typedef uint32_t u32x2 __attribute__((ext_vector_type(2)));
#define DI __device__ __forceinline__
#define MFMA(a, b, c) __builtin_amdgcn_mfma_f32_32x32x16_bf16((a), (b), (c), 0, 0, 0)

constexpr int DM = 1024, NB = 8, SEQ = 4096, CTXL = 256, TALL = 4352, NLAT = NB * SEQ, TT = NLAT + NB * CTXL, DEPTH = 4;
constexpr int NIN = 2816, DIN_SRC = 2752;
constexpr int C_CQ = 0, C_CKV = 256, C_GQ = 512, C_GK = 896, C_GV = 1024, C_LQ = 1152, C_LK = 1280, C_LV = 1408, C_LA = 1664, C_KR = 1696, C_Z = 1792;
constexpr float EPS = 1e-6f;
constexpr float LOG2E = 1.4426950408889634f;
constexpr int NPHASE = 2 + 5 * DEPTH + 1;

constexpr size_t SZ_WIN = (size_t)4 * NIN * 1024 * 2, SZ_WOUT = (size_t)4 * 1024 * 1024 * 2, SZ_WUQ = (size_t)4 * 640 * 256 * 2, SZ_WUKV = (size_t)4 * 768 * 256 * 2;
constexpr size_t SZ_MOD = (size_t)4 * 9 * 3072 * 4, SZ_BIAS = (size_t)4 * 9 * NIN * 4, SZ_ROPE = 12288, SZ_RSS = (size_t)TT * 16 * 4, SZ_CSS = (size_t)TT * 8 * 4;
constexpr size_t SZ_CTXX = (size_t)2048 * 1024 * 4, SZ_XG = (size_t)TT * 1024 * 2, SZ_U = (size_t)TT * NIN * 2;
constexpr size_t SZ_QM = (size_t)NB * 6 * TALL * 96 * 2, SZ_QG = (size_t)NB * 6 * TALL * 64 * 2, SZ_VTM = (size_t)NB * 6 * 64 * TALL * 2, SZ_KG = (size_t)NB * 2 * TALL * 64 * 2;
constexpr size_t SZ_CUM = (size_t)2 * TT * 128 * 4, SZ_DS = (size_t)2 * NB * 68 * 4 * 2048 * 4, SZ_LAST = (size_t)2 * NB * 68 * 4 * 32 * 4;
constexpr size_t OFF_WIN = 0, OFF_WOUT = OFF_WIN + SZ_WIN, OFF_WUQ = OFF_WOUT + SZ_WOUT, OFF_WUKV = OFF_WUQ + SZ_WUQ, OFF_MOD = OFF_WUKV + SZ_WUKV, OFF_BIAS = OFF_MOD + SZ_MOD,
                 OFF_ROPE = OFF_BIAS + SZ_BIAS, OFF_RSS = OFF_ROPE + SZ_ROPE, OFF_CSS = OFF_RSS + SZ_RSS, OFF_CTXX = OFF_CSS + SZ_CSS, OFF_XG = OFF_CTXX + SZ_CTXX,
                 OFF_QM = OFF_XG, OFF_QG = OFF_XG + SZ_QM,
                 OFF_U = OFF_XG + SZ_XG, OFF_KM = OFF_U + SZ_U, OFF_VTM = OFF_KM + SZ_QM, OFF_KG = OFF_VTM + SZ_VTM, OFF_VTG = OFF_KG + SZ_KG, OFF_CUM = OFF_VTG + SZ_KG,
                 OFF_DS = OFF_CUM + SZ_CUM, OFF_LAST = OFF_DS + SZ_DS, OFF_SPREV = OFF_LAST + SZ_LAST, OFF_BAR = OFF_SPREV + SZ_DS, SZ_BAR = (3456 + 64 * 64) * 4, WS_TOTAL = OFF_BAR + SZ_BAR;
static_assert(SZ_QM + SZ_QG <= SZ_XG, "Q overlay");

struct Params {
    const float *x, *c, *ctx, *c_ctx, *norm_w, *w_mod, *b_mod, *w_in, *wa_f, *ba_f, *wa_b, *ba_b, *gla_nw, *mla_qnw, *w_uq, *mla_kvnw, *w_ukv, *gqa_qnw, *gqa_knw, *w_out, *final_nw;
    float* out;
    char* ws;
    int phase_begin, phase_end;
};

DI uint32_t pack2(float a, float b) { f2_t v = {a, b}; bf2_t r = __builtin_convertvector(v, bf2_t); return __builtin_bit_cast(uint32_t, r); }
DI u16 f2bf(float a) { return (u16)(pack2(a, 0.f) & 0xffffu); }
DI float bf2f(u16 v) { return __uint_as_float((uint32_t)v << 16); }
DI float bflo(uint32_t v) { return __uint_as_float(v << 16); }
DI float bfhi(uint32_t v) { return __uint_as_float(v & 0xffff0000u); }
DI int otid() { int t = threadIdx.x; asm volatile("" : "+v"(t)); return t; }
DI float xhalf_max(float x) { const unsigned u = __float_as_uint(x); auto r = __builtin_amdgcn_permlane32_swap(u, u, false, false); return fmaxf(__uint_as_float(r[0]), __uint_as_float(r[1])); }
DI float xhalf_sum(float x) { const unsigned u = __float_as_uint(x); auto r = __builtin_amdgcn_permlane32_swap(u, u, false, false); return __uint_as_float(r[0]) + __uint_as_float(r[1]); }
DI float max3f(float a, float b, float c) { float r; asm("v_max3_f32 %0, %1, %2, %3" : "=v"(r) : "v"(a), "v"(b), "v"(c)); return r; }
DI u32x4 pair16(u32x2 lo, u32x2 hi) {
    auto a = __builtin_amdgcn_permlane32_swap(lo.x, hi.x, false, false);
    auto b = __builtin_amdgcn_permlane32_swap(lo.y, hi.y, false, false);
    u32x4 r; r.x = a[0]; r.y = b[0]; r.z = a[1]; r.w = b[1]; return r;
}
DI void mfence() { asm volatile("" ::: "memory"); }
DI float silu(float v) { return v / (1.f + __expf(-v)); }
DI float wave_sum(float v) {
    v += __shfl_xor(v, 1); v += __shfl_xor(v, 2); v += __shfl_xor(v, 4); v += __shfl_xor(v, 8); v += __shfl_xor(v, 16); v += __shfl_xor(v, 32); return v;
}
DI int srccol(int n) {
    if (n < 256) return 800 + n;
    if (n < 512) return 1056 + n - 256;
    if (n < 896) return 1728 + n - 512;
    if (n < 1024) return 2112 + n - 896;
    if (n < 1152) return 2240 + n - 1024;
    if (n < 1280) return n - 1152;
    if (n < 1408) return 128 + n - 1280;
    if (n < 1664) return 256 + n - 1408;
    if (n < 1696) return 768 + n - 1664;
    if (n < 1728) return 1312 + n - 1696;
    if (n < 1792) return -1;
    if (n < 2048) return 512 + n - 1792;
    if (n < 2432) return 1344 + n - 2048;
    return 2368 + n - 2432;
}
struct RowInfo { int b, t, tall, lat; };
DI RowInfo rowinfo(int row) {
    RowInfo r;
    if (row < NLAT) { r.b = row >> 12; r.t = row & 4095; r.tall = 256 + r.t; r.lat = 1; }
    else { int rr = row - NLAT; r.b = rr >> 8; r.t = rr & 255; r.tall = r.t; r.lat = 0; }
    return r;
}

constexpr int TM = 256;
struct NoPrefetch { DI void operator()() const {} };
template <class PF = NoPrefetch>
DI void gemm_core(const u16* __restrict__ Wp, int ldw, const u16* __restrict__ Xp, int ldx, int K, u16* sbase, f32x16 (&acc)[2][4], PF&& pf = PF()) {
    const int tid = otid(), wave = tid >> 6, lane = tid & 63, r = lane & 31, h = lane >> 5, wf = wave & 1, wt = wave >> 1;
    const int lrow = tid >> 3, lc = (tid & 7) * 8;
    const u16* wsrc = Wp + (size_t)lrow * ldw + lc;
    const u16* xsrc = Xp + (size_t)lrow * ldx + lc;
    u16* sW = sbase; u16* sX = sbase + 128 * 72;
    const int nk = K >> 6;
    u32x4 rg[12];
#define G_LOAD(kt) { _Pragma("unroll") for (int i = 0; i < 4; ++i) rg[i] = *(const u32x4*)(wsrc + (size_t)(32 * i) * ldw + (kt) * 64); \
                     _Pragma("unroll") for (int i = 0; i < 8; ++i) rg[4 + i] = *(const u32x4*)(xsrc + (size_t)(32 * i) * ldx + (kt) * 64); }
#define G_STORE() { _Pragma("unroll") for (int i = 0; i < 4; ++i) *(u32x4*)(sW + (lrow + 32 * i) * 72 + lc) = rg[i]; \
                    _Pragma("unroll") for (int i = 0; i < 8; ++i) *(u32x4*)(sX + (lrow + 32 * i) * 72 + lc) = rg[4 + i]; }
#define G_FRAGS(F, ks) { _Pragma("unroll") for (int q = 0; q < 2; ++q) F[q] = *(const bf16x8*)(sW + (wf * 64 + q * 32 + r) * 72 + (ks) * 16 + h * 8); \
                         _Pragma("unroll") for (int q = 0; q < 4; ++q) F[2 + q] = *(const bf16x8*)(sX + (wt * 128 + q * 32 + r) * 72 + (ks) * 16 + h * 8); }
#define G_MMA(F) { _Pragma("unroll") for (int fb = 0; fb < 2; ++fb) _Pragma("unroll") for (int tb = 0; tb < 4; ++tb) acc[fb][tb] = MFMA(F[fb], F[2 + tb], acc[fb][tb]); }
#define SCHED_FENCE() __builtin_amdgcn_sched_barrier(0)
    G_LOAD(0);
    for (int k = 0; k < nk; ++k) {
        __syncthreads();
        G_STORE();
        __syncthreads();
        {
            bf16x8 fw[2], fx[4];
#define RD_W(ks) { _Pragma("unroll") for (int q = 0; q < 2; ++q) fw[q] = *(const bf16x8*)(sW + (wf * 64 + q * 32 + r) * 72 + (ks) * 16 + h * 8); }
#define RD_X(q, ks) { fx[q] = *(const bf16x8*)(sX + (wt * 128 + (q) * 32 + r) * 72 + (ks) * 16 + h * 8); }
            RD_W(0); RD_X(0, 0); RD_X(1, 0); RD_X(2, 0); RD_X(3, 0); SCHED_FENCE();
            if (k + 1 < nk) { G_LOAD(k + 1); } else { pf(); }
            SCHED_FENCE();
#pragma unroll
            for (int ks = 0; ks < 4; ++ks) {
#pragma unroll
                for (int tb = 0; tb < 4; ++tb) {
                    acc[0][tb] = MFMA(fw[0], fx[tb], acc[0][tb]);
                    acc[1][tb] = MFMA(fw[1], fx[tb], acc[1][tb]);
                    SCHED_FENCE();
                    if (ks < 3) { RD_X(tb, ks + 1); SCHED_FENCE(); }
                }
                if (ks < 3) { RD_W(ks + 1); SCHED_FENCE(); }
            }
#undef RD_W
#undef RD_X
        }
    }
#undef G_LOAD
#undef G_STORE
#undef G_FRAGS
#undef G_MMA
#undef SCHED_FENCE
}
DI void zero_acc(f32x16 (&acc)[2][4]) {
#pragma unroll
    for (int a = 0; a < 2; ++a)
#pragma unroll
        for (int b = 0; b < 4; ++b)
#pragma unroll
            for (int i = 0; i < 16; ++i) acc[a][b][i] = 0.f;
}

DI void tconv_tile(const float* __restrict__ src, int ldsrc, int nsrc, int mode, int k0, int n0, const float* __restrict__ kscale, u16* __restrict__ dst, int lddst, float* sm) {
    const int tid = otid();
    __syncthreads();
#pragma unroll 4
    for (int i = 0; i < 16; ++i) {
        const int idx = tid + 256 * i, kk = idx >> 6, nn = idx & 63, n = n0 + nn;
        const int sc = mode ? srccol(n) : (n < nsrc ? n : -1);
        float v = 0.f;
        if (sc >= 0) v = src[(size_t)(k0 + kk) * ldsrc + sc];
        if (kscale) v *= kscale[k0 + kk];
        sm[kk * 65 + nn] = v;
    }
    __syncthreads();
#pragma unroll 4
    for (int i = 0; i < 8; ++i) {
        const int idx = tid + 256 * i, nn = idx >> 5, kp = idx & 31;
        *(uint32_t*)(dst + (size_t)(n0 + nn) * lddst + k0 + 2 * kp) = pack2(sm[(2 * kp) * 65 + nn], sm[(2 * kp + 1) * 65 + nn]);
    }
}

constexpr int N_WCONV = 704 + 256 + 40 + 48;
DI void wconv_item(const Params& p, int l, int i, float* smf) {
    if (i < 704) { const int nt = i / 16, kt = i % 16;
        tconv_tile(p.w_in + (size_t)l * 1024 * DIN_SRC, DIN_SRC, DIN_SRC, 1, kt * 64, nt * 64, nullptr, (u16*)(p.ws + OFF_WIN) + (size_t)l * NIN * 1024, 1024, smf); return; }
    i -= 704;
    if (i < 256) { const int nt = i / 16, kt = i % 16;
        tconv_tile(p.w_out + (size_t)l * 1024 * 1024, 1024, 1024, 0, kt * 64, nt * 64, nullptr, (u16*)(p.ws + OFF_WOUT) + (size_t)l * 1024 * 1024, 1024, smf); return; }
    i -= 256;
    if (i < 40) { const int nt = i / 4, kt = i % 4;
        tconv_tile(p.w_uq + (size_t)l * 256 * 576, 576, 576, 0, kt * 64, nt * 64, p.mla_qnw + l * 256, (u16*)(p.ws + OFF_WUQ) + (size_t)l * 640 * 256, 256, smf); return; }
    i -= 40;
    { const int nt = i / 4, kt = i % 4;
        tconv_tile(p.w_ukv + (size_t)l * 256 * 768, 768, 768, 0, kt * 64, nt * 64, p.mla_kvnw + l * 256, (u16*)(p.ws + OFF_WUKV) + (size_t)l * 768 * 256, 256, smf); }
}
DI void bias_item(const Params& p, int l, int cgp, char* smem) {
    const int tid = otid();
    float* smf = (float*)smem;
    const float* MOD = (const float*)(p.ws + OFF_MOD);
    __syncthreads();
    for (int idx = tid; idx < 9 * 1024; idx += 256) smf[idx] = MOD[(size_t)(l * 9 + (idx >> 10)) * 3072 + (idx & 1023)];
    __syncthreads();
    const int kg = tid >> 4, q = tid & 15, sc = srccol(cgp * 64 + q * 4);
    float acc[9][4];
#pragma unroll
    for (int j = 0; j < 9; ++j) { acc[j][0] = 0.f; acc[j][1] = 0.f; acc[j][2] = 0.f; acc[j][3] = 0.f; }
    if (sc >= 0) {
        const float* wp = p.w_in + ((size_t)l * 1024 + kg * 64) * DIN_SRC + sc;
#pragma unroll 8
        for (int kk = 0; kk < 64; ++kk) {
            const float4 w = *(const float4*)(wp + (size_t)kk * DIN_SRC);
#pragma unroll
            for (int j = 0; j < 9; ++j) { const float sv = smf[j * 1024 + kg * 64 + kk]; acc[j][0] += sv * w.x; acc[j][1] += sv * w.y; acc[j][2] += sv * w.z; acc[j][3] += sv * w.w; }
        }
    }
    __syncthreads();
#pragma unroll
    for (int j = 0; j < 9; ++j) *(float4*)(smf + (kg * 9 + j) * 64 + q * 4) = make_float4(acc[j][0], acc[j][1], acc[j][2], acc[j][3]);
    __syncthreads();
    float* BIAS = (float*)(p.ws + OFF_BIAS);
    for (int idx = tid; idx < 9 * 64; idx += 256) {
        const int j = idx >> 6, ln = idx & 63;
        float sm = 0.f;
#pragma unroll
        for (int g = 0; g < 16; ++g) sm += smf[(g * 9 + j) * 64 + ln];
        BIAS[(size_t)(l * 9 + j) * NIN + cgp * 64 + ln] = sm;
    }
}

DI void phase0(const Params& p, char* smem) {
    const int tid = otid(), wave = tid >> 6, lane = tid & 63;
    float* smf = (float*)smem;
    constexpr int N_MOD = 4 * 48;
    constexpr int TOT = N_MOD + N_WCONV + 1;
    for (int it = blockIdx.x; it < TOT; it += gridDim.x) {
        int i = it;
        if (i < N_MOD) {
            const int l = i / 48, cgp = i % 48;
            __syncthreads();
            for (int idx = tid; idx < 9 * 1024; idx += 256) {
                const int j = idx >> 10, k = idx & 1023;
                const float cv = j < 8 ? p.c[j * 1024 + k] : p.c_ctx[k];
                smf[idx] = silu(cv);
            }
            __syncthreads();
            const int kg = tid >> 4, q = tid & 15;
            float acc[9][4];
#pragma unroll
            for (int j = 0; j < 9; ++j) { acc[j][0] = 0.f; acc[j][1] = 0.f; acc[j][2] = 0.f; acc[j][3] = 0.f; }
            const float* wp = p.w_mod + ((size_t)l * 1024 + kg * 64) * 3072 + cgp * 64 + q * 4;
#pragma unroll 8
            for (int kk = 0; kk < 64; ++kk) {
                const float4 w = *(const float4*)(wp + (size_t)kk * 3072);
#pragma unroll
                for (int j = 0; j < 9; ++j) { const float sv = smf[j * 1024 + kg * 64 + kk]; acc[j][0] += sv * w.x; acc[j][1] += sv * w.y; acc[j][2] += sv * w.z; acc[j][3] += sv * w.w; }
            }
            __syncthreads();
#pragma unroll
            for (int j = 0; j < 9; ++j) *(float4*)(smf + (kg * 9 + j) * 64 + q * 4) = make_float4(acc[j][0], acc[j][1], acc[j][2], acc[j][3]);
            __syncthreads();
            float* MOD = (float*)(p.ws + OFF_MOD);
            for (int idx = tid; idx < 9 * 64; idx += 256) {
                const int j = idx >> 6, ln = idx & 63;
                float sm = p.b_mod[l * 3072 + cgp * 64 + ln];
#pragma unroll
                for (int g = 0; g < 16; ++g) sm += smf[(g * 9 + j) * 64 + ln];
                MOD[(size_t)(l * 9 + j) * 3072 + cgp * 64 + ln] = sm;
            }
            continue;
        }
        i -= N_MOD;
        if (i < N_WCONV) { wconv_item(p, 0, i, smf); continue; }
        {
            float* rope = (float*)(p.ws + OFF_ROPE);
            for (int idx = tid; idx < 64 * 16 + 64 * 8; idx += 256) {
                int pos, f, quarter; float *cd, *sd;
                if (idx < 1024) { pos = idx >> 4; f = idx & 15; quarter = 16; cd = rope + idx; sd = rope + 1024 + idx; }
                else { const int j = idx - 1024; pos = j >> 3; f = j & 7; quarter = 8; cd = rope + 2048 + j; sd = rope + 2560 + j; }
                const float freq = exp2f(-(float)f / (float)quarter * 13.287712379549449f);
                const float ang = (float)pos * freq;
                float rev = ang * 0.15915494309189535f; rev -= rintf(rev);
                *cd = __builtin_amdgcn_cosf(rev); *sd = __builtin_amdgcn_sinf(rev);
            }
        }
    }
}

DI void phase1(const Params& p, char* smem) {
    const int tid = otid(), wave = tid >> 6, lane = tid & 63;
    float* smf = (float*)smem;
    const float* MOD = (const float*)(p.ws + OFF_MOD);
    constexpr int N_ROWS = TT / 32, N_BIAS = 44;
    for (int it = blockIdx.x; it < N_ROWS + N_BIAS; it += gridDim.x) {
        if (it < N_BIAS) { bias_item(p, 0, it, smem); continue; }
        const int row0 = (it - N_BIAS) * 32 + wave * 8;
        const int j = row0 < NLAT ? (row0 >> 12) : 8;
        float4 g[4];
#pragma unroll
        for (int i = 0; i < 4; ++i) {
            const int col = lane * 4 + 256 * i;
            const float4 nw = *(const float4*)(p.norm_w + col), sc = *(const float4*)(MOD + (size_t)j * 3072 + 1024 + col);
            g[i] = make_float4(nw.x * (1.f + sc.x), nw.y * (1.f + sc.y), nw.z * (1.f + sc.z), nw.w * (1.f + sc.w));
        }
        for (int rr = 0; rr < 8; ++rr) {
            const int row = row0 + rr;
            const float* src = row < NLAT ? p.x + (size_t)row * 1024 : p.ctx + (size_t)(row - NLAT) * 1024;
            float ss = 0.f;
#pragma unroll
            for (int i = 0; i < 4; ++i) {
                const int col = lane * 4 + 256 * i;
                const float4 v = *(const float4*)(src + col);
                ss += v.x * v.x + v.y * v.y + v.z * v.z + v.w * v.w;
                u32x2 o; o.x = pack2(v.x * g[i].x, v.y * g[i].y); o.y = pack2(v.z * g[i].z, v.w * g[i].w);
                *(u32x2*)((u16*)(p.ws + OFF_XG) + (size_t)row * 1024 + col) = o;
                if (row >= NLAT) *(float4*)((float*)(p.ws + OFF_CTXX) + (size_t)(row - NLAT) * 1024 + col) = v;
            }
            ss = wave_sum(ss);
            if (lane < 16) ((float*)(p.ws + OFF_RSS))[(size_t)row * 16 + lane] = lane == 0 ? ss : 0.f;
        }
    }
}

DI void inproj_tile(const Params& p, int l, int mt, int nt, char* smem) {
    const int tid = otid(), wave = tid >> 6, lane = tid & 63, r = lane & 31, h = lane >> 5, wf = wave & 1, wt = wave >> 1;
    u16* sW = (u16*)smem;
    f32x16 acc[2][4]; zero_acc(acc);
    const int j = mt < 128 ? (mt >> 4) : 8;
    const float* bias = (const float*)(p.ws + OFF_BIAS) + (size_t)(l * 9 + j) * NIN;
    const float* RSS = (const float*)(p.ws + OFF_RSS);
    const int n0 = nt * 128 + wf * 64;
    float4 rs4[4][4], bv4[2][4];
    gemm_core((const u16*)(p.ws + OFF_WIN) + ((size_t)l * NIN + nt * 128) * 1024, 1024, (const u16*)(p.ws + OFF_XG) + (size_t)mt * TM * 1024, 1024, 1024, sW, acc, [&]() {
#pragma unroll
        for (int tb = 0; tb < 4; ++tb)
#pragma unroll
            for (int q = 0; q < 4; ++q) rs4[tb][q] = *(const float4*)(RSS + (size_t)(mt * TM + wt * 128 + tb * 32 + r) * 16 + 4 * q);
#pragma unroll
        for (int fb = 0; fb < 2; ++fb)
#pragma unroll
            for (int g4 = 0; g4 < 4; ++g4) bv4[fb][g4] = *(const float4*)(bias + n0 + fb * 32 + 8 * g4 + 4 * h);
    });
    u16* U = (u16*)(p.ws + OFF_U);
    u16* sO = (u16*)smem;
    __syncthreads();
#pragma unroll
    for (int tb = 0; tb < 4; ++tb) {
        const int row = mt * TM + wt * 128 + tb * 32 + r;
        float s = 0.f;
#pragma unroll
        for (int q = 0; q < 4; ++q) { const float4 v = rs4[tb][q]; s += (v.x + v.y) + (v.z + v.w); }
        const float rstd = rsqrtf(s * (1.f / 1024.f) + EPS);
        float ss = 0.f;
#pragma unroll
        for (int fb = 0; fb < 2; ++fb)
#pragma unroll
            for (int g4 = 0; g4 < 4; ++g4) {
                const int n = n0 + fb * 32 + 8 * g4 + 4 * h;
                const float4 bv = bv4[fb][g4];
                const float v0 = acc[fb][tb][4 * g4 + 0] * rstd + bv.x, v1 = acc[fb][tb][4 * g4 + 1] * rstd + bv.y, v2 = acc[fb][tb][4 * g4 + 2] * rstd + bv.z,
                            v3 = acc[fb][tb][4 * g4 + 3] * rstd + bv.w;
                ss += v0 * v0 + v1 * v1 + v2 * v2 + v3 * v3;
                u32x2 o; o.x = pack2(v0, v1); o.y = pack2(v2, v3);
                *(u32x2*)(sO + (wt * 128 + tb * 32 + r) * 136 + wf * 64 + fb * 32 + 8 * g4 + 4 * h) = o;
            }
        if (nt < 4) {
            ss += __shfl_xor(ss, 32);
            if (h == 0) ((float*)(p.ws + OFF_CSS))[(size_t)row * 8 + nt * 2 + wf] = ss;
        }
    }
    __syncthreads();
#pragma unroll 4
    for (int i = 0; i < 16; ++i) {
        const int idx = tid + 256 * i, rr = idx >> 4, ch = idx & 15;
        *(u32x4*)(U + (size_t)(mt * TM + rr) * NIN + nt * 128 + ch * 8) = *(const u32x4*)(sO + rr * 136 + ch * 8);
    }
}

DI void upproj_tile(const Params& p, int l, int mt, int nt, char* smem) {
    const int tid = otid(), wave = tid >> 6, lane = tid & 63, r = lane & 31, h = lane >> 5, wf = wave & 1, wt = wave >> 1;
    u16* sW = (u16*)smem;
    f32x16 acc[2][4]; zero_acc(acc);
    const u16* U = (const u16*)(p.ws + OFF_U);
    const bool isq = nt < 5;
    const u16* W = isq ? (const u16*)(p.ws + OFF_WUQ) + ((size_t)l * 640 + nt * 128) * 256 : (const u16*)(p.ws + OFF_WUKV) + ((size_t)l * 768 + (nt - 5) * 128) * 256;
    gemm_core(W, 256, U + (size_t)mt * TM * NIN + (isq ? C_CQ : C_CKV), NIN, 256, sW, acc);
    const float* CSS = (const float*)(p.ws + OFF_CSS);
    const float* rope = (const float*)(p.ws + OFF_ROPE);
    u16* QM = (u16*)(p.ws + OFF_QM); u16* KM = (u16*)(p.ws + OFF_KM); u16* VTM = (u16*)(p.ws + OFF_VTM);
#pragma unroll
    for (int tb = 0; tb < 4; ++tb) {
        const int row = mt * TM + wt * 128 + tb * 32 + r;
        const RowInfo ri = rowinfo(row);
        const float4 cs4 = *(const float4*)(CSS + (size_t)row * 8 + (isq ? 0 : 4));
        float rstd = rsqrtf(((cs4.x + cs4.y) + (cs4.z + cs4.w)) * (1.f / 256.f) + EPS);
        if (isq) {
            rstd *= 0.10206207261596577f * LOG2E;
#pragma unroll
            for (int fb = 0; fb < 2; ++fb)
#pragma unroll
                for (int hh = 0; hh < 2; ++hh) {
                    const int n16 = nt * 128 + wf * 64 + fb * 32 + 16 * hh;
                    if (n16 >= 576) continue;
                    const int head = n16 / 96, d16 = n16 - head * 96;
                    float lo[4], hi[4];
#pragma unroll
                    for (int e = 0; e < 4; ++e) { lo[e] = acc[fb][tb][8 * hh + e] * rstd; hi[e] = acc[fb][tb][8 * hh + 4 + e] * rstd; }
                    if (d16 >= 64 && ri.lat) {
                        const int axis = (d16 - 64) >> 4, pos = axis ? (ri.t & 63) : (ri.t >> 6);
                        const float4 c4 = *(const float4*)(rope + 2048 + pos * 8 + 4 * h), s4 = *(const float4*)(rope + 2560 + pos * 8 + 4 * h);
                        const float cc[4] = {c4.x, c4.y, c4.z, c4.w}, sn[4] = {s4.x, s4.y, s4.z, s4.w};
#pragma unroll
                        for (int e = 0; e < 4; ++e) { const float x1 = lo[e], x2 = hi[e]; lo[e] = x1 * cc[e] - x2 * sn[e]; hi[e] = x2 * cc[e] + x1 * sn[e]; }
                    }
                    u16* dst = QM + ((size_t)(ri.b * 6 + head) * TALL + ri.tall) * 96 + d16 + 8 * h;
                    u32x2 ol, oh; ol.x = pack2(lo[0], lo[1]); ol.y = pack2(lo[2], lo[3]); oh.x = pack2(hi[0], hi[1]); oh.y = pack2(hi[2], hi[3]);
                    *(u32x4*)dst = pair16(ol, oh);
                }
        } else {
            const int head = nt - 5;
            if (wf == 0) {
                u16* dst = KM + ((size_t)(ri.b * 6 + head) * TALL + ri.tall) * 96;
#pragma unroll
                for (int fb = 0; fb < 2; ++fb)
#pragma unroll
                    for (int g2 = 0; g2 < 2; ++g2) {
                        u32x2 ol, oh;
                        ol.x = pack2(acc[fb][tb][8 * g2] * rstd, acc[fb][tb][8 * g2 + 1] * rstd); ol.y = pack2(acc[fb][tb][8 * g2 + 2] * rstd, acc[fb][tb][8 * g2 + 3] * rstd);
                        oh.x = pack2(acc[fb][tb][8 * g2 + 4] * rstd, acc[fb][tb][8 * g2 + 5] * rstd); oh.y = pack2(acc[fb][tb][8 * g2 + 6] * rstd, acc[fb][tb][8 * g2 + 7] * rstd);
                        *(u32x4*)(dst + fb * 32 + 16 * g2 + 8 * h) = pair16(ol, oh);
                    }
            } else {
                u16* dst = VTM + (size_t)(ri.b * 6 + head) * 64 * TALL + ri.tall;
#pragma unroll
                for (int fb = 0; fb < 2; ++fb)
#pragma unroll
                    for (int i = 0; i < 16; ++i) {
                        const int dv = fb * 32 + (i & 3) + 8 * (i >> 2) + 4 * h;
                        dst[(size_t)dv * TALL] = f2bf(acc[fb][tb][i] * rstd);
                    }
            }
        }
    }
}

DI void tokpost_item(const Params& p, int l, int it, char* smem) {
    const int tid = otid(), wave = tid >> 6, lane = tid & 63;
    const u16* U = (const u16*)(p.ws + OFF_U);
    const float* rope = (const float*)(p.ws + OFF_ROPE);
    u16* QG = (u16*)(p.ws + OFF_QG); u16* KG = (u16*)(p.ws + OFF_KG); u16* VTG = (u16*)(p.ws + OFF_VTG); u16* KM = (u16*)(p.ws + OFF_KM);
    u16* sT = (u16*)smem;
    const int row0 = it * 32;
    const int hd = lane >> 3, c = lane & 7;
    const int part = lane & 3, kh = lane >> 2;
    __syncthreads();
    u32x4 raw[8], kr[8], vr[2];
#pragma unroll
    for (int tk = 0; tk < 8; ++tk) {
        const int row = row0 + wave * 8 + tk;
        raw[tk] = *(const u32x4*)(U + (size_t)row * NIN + C_GQ + lane * 8);
        kr[tk] = *(const u32x4*)(U + (size_t)row * NIN + C_KR + part * 8);
    }
#pragma unroll
    for (int i = 0; i < 2; ++i) { const int idx = tid + 256 * i, tok = idx >> 4, ch = idx & 15; vr[i] = *(const u32x4*)(U + (size_t)(row0 + tok) * NIN + C_GV + ch * 8); }
    float w[8];
    { const float* wp = (hd < 6 ? p.gqa_qnw : p.gqa_knw) + l * 64 + c * 8;
      const float4 a = *(const float4*)wp, b = *(const float4*)(wp + 4); w[0] = a.x; w[1] = a.y; w[2] = a.z; w[3] = a.w; w[4] = b.x; w[5] = b.y; w[6] = b.z; w[7] = b.w; }
    const float osc = hd < 6 ? 0.125f * LOG2E : 1.f;
#pragma unroll
    for (int i = 0; i < 2; ++i) { const int idx = tid + 256 * i, tok = idx >> 4, ch = idx & 15; *(u32x4*)(sT + tok * 136 + ch * 8) = vr[i]; }
#pragma unroll
    for (int tk = 0; tk < 8; ++tk) {
        const int row = row0 + wave * 8 + tk;
        const RowInfo ri = rowinfo(row);
        float v[8] = {bflo(raw[tk].x), bfhi(raw[tk].x), bflo(raw[tk].y), bfhi(raw[tk].y), bflo(raw[tk].z), bfhi(raw[tk].z), bflo(raw[tk].w), bfhi(raw[tk].w)};
        float ss = 0.f;
#pragma unroll
        for (int e = 0; e < 8; ++e) ss += v[e] * v[e];
        ss += __shfl_xor(ss, 1); ss += __shfl_xor(ss, 2); ss += __shfl_xor(ss, 4);
        const float rstd = rsqrtf(ss * (1.f / 64.f) + EPS);
#pragma unroll
        for (int e = 0; e < 8; ++e) v[e] = v[e] * rstd * w[e];
        float pr[8];
#pragma unroll
        for (int e = 0; e < 8; ++e) pr[e] = __shfl_xor(v[e], 2);
        if (ri.lat) {
            const int axis = c >> 2, half = (c >> 1) & 1, f0 = (c & 1) * 8, pos = axis ? (ri.t & 63) : (ri.t >> 6);
            const float4 c0 = *(const float4*)(rope + pos * 16 + f0), c1 = *(const float4*)(rope + pos * 16 + f0 + 4);
            const float4 s0 = *(const float4*)(rope + 1024 + pos * 16 + f0), s1 = *(const float4*)(rope + 1024 + pos * 16 + f0 + 4);
            const float cs[8] = {c0.x, c0.y, c0.z, c0.w, c1.x, c1.y, c1.z, c1.w}, sn[8] = {s0.x, s0.y, s0.z, s0.w, s1.x, s1.y, s1.z, s1.w};
#pragma unroll
            for (int e = 0; e < 8; ++e) v[e] = half ? (v[e] * cs[e] + pr[e] * sn[e]) : (v[e] * cs[e] - pr[e] * sn[e]);
        }
        u32x4 o; o.x = pack2(v[0] * osc, v[1] * osc); o.y = pack2(v[2] * osc, v[3] * osc); o.z = pack2(v[4] * osc, v[5] * osc); o.w = pack2(v[6] * osc, v[7] * osc);
        if (hd < 6) *(u32x4*)(QG + ((size_t)(ri.b * 6 + hd) * TALL + ri.tall) * 64 + c * 8) = o;
        else *(u32x4*)(KG + ((size_t)(ri.b * 2 + hd - 6) * TALL + ri.tall) * 64 + c * 8) = o;
        {
            float kv[8] = {bflo(kr[tk].x), bfhi(kr[tk].x), bflo(kr[tk].y), bfhi(kr[tk].y), bflo(kr[tk].z), bfhi(kr[tk].z), bflo(kr[tk].w), bfhi(kr[tk].w)};
            float kp[8];
#pragma unroll
            for (int e = 0; e < 8; ++e) kp[e] = __shfl_xor(kv[e], 1);
            if (ri.lat) {
                const int ax = part >> 1, hf = part & 1, ps = ax ? (ri.t & 63) : (ri.t >> 6);
                const float4 c0 = *(const float4*)(rope + 2048 + ps * 8), c1 = *(const float4*)(rope + 2048 + ps * 8 + 4);
                const float4 s0 = *(const float4*)(rope + 2560 + ps * 8), s1 = *(const float4*)(rope + 2560 + ps * 8 + 4);
                const float cs[8] = {c0.x, c0.y, c0.z, c0.w, c1.x, c1.y, c1.z, c1.w}, sn[8] = {s0.x, s0.y, s0.z, s0.w, s1.x, s1.y, s1.z, s1.w};
#pragma unroll
                for (int e = 0; e < 8; ++e) kv[e] = hf ? (kv[e] * cs[e] + kp[e] * sn[e]) : (kv[e] * cs[e] - kp[e] * sn[e]);
            }
            u32x4 ko; ko.x = pack2(kv[0], kv[1]); ko.y = pack2(kv[2], kv[3]); ko.z = pack2(kv[4], kv[5]); ko.w = pack2(kv[6], kv[7]);
            if (lane < 24) *(u32x4*)(KM + ((size_t)(ri.b * 6 + kh) * TALL + ri.tall) * 96 + 64 + part * 8) = ko;
        }
    }
    __syncthreads();
    {
        const RowInfo r0 = rowinfo(row0);
        const int feat = tid >> 1, hf = tid & 1;
        u32x4 o0, o1;
#pragma unroll
        for (int e = 0; e < 4; ++e) {
            o0[e] = (uint32_t)sT[(hf * 16 + 2 * e) * 136 + feat] | ((uint32_t)sT[(hf * 16 + 2 * e + 1) * 136 + feat] << 16);
            o1[e] = (uint32_t)sT[(hf * 16 + 8 + 2 * e) * 136 + feat] | ((uint32_t)sT[(hf * 16 + 8 + 2 * e + 1) * 136 + feat] << 16);
        }
        u16* dst = VTG + ((size_t)(r0.b * 2 + (feat >> 6)) * 64 + (feat & 63)) * TALL + r0.tall + hf * 16;
        *(u32x4*)dst = o0; *(u32x4*)(dst + 8) = o1;
    }
}

DI int chunk_row0(int b, int g) { return g < 4 ? NLAT + b * 256 + g * 64 : b * 4096 + (g - 4) * 64; }
DI void gla_local_item(const Params& p, int l, int it, char* smem) {
    const int tid = otid();
    const int h = it & 3, g = (it >> 2) % 68, b = it / (4 * 68);
    const int row0 = chunk_row0(b, g);
    const u16* U = (const u16*)(p.ws + OFF_U);
    float* sA = (float*)smem;
    float* sWa = sA + 64 * 33;
    float* sG = sWa + 2 * 16 * 32;
    u16* sV = (u16*)(sG + 2 * 64 * 33);
    float* sLast = (float*)(sV + 64 * 64);
    float* sSeg = sLast + 64;
    const int t = tid >> 2, c0 = (tid & 3) * 8;
    __syncthreads();
    const u32x4 araw = *(const u32x4*)(U + (size_t)(row0 + t) * NIN + C_LA + c0);
    const u32x4 kraw = *(const u32x4*)(U + (size_t)(row0 + t) * NIN + C_LK + h * 32 + c0);
    u32x4 vraw[2];
#pragma unroll
    for (int i = 0; i < 2; ++i) { const int idx = tid + 256 * i, tt = idx >> 3, ch = idx & 7; vraw[i] = *(const u32x4*)(U + (size_t)(row0 + tt) * NIN + C_LV + h * 64 + ch * 8); }
    float wreg[4];
#pragma unroll
    for (int i = 0; i < 4; ++i) { const int idx = tid + 256 * i, d = idx >> 9, rr = (idx >> 5) & 15, c = idx & 31; wreg[i] = (d ? p.wa_b : p.wa_f)[((size_t)l * 16 + rr) * 128 + h * 32 + c]; }
    float bias[2][8];
#pragma unroll
    for (int d = 0; d < 2; ++d) {
        const float* bp = (d ? p.ba_b : p.ba_f) + l * 128 + h * 32 + c0;
        const float4 b0 = *(const float4*)bp, b1 = *(const float4*)(bp + 4);
        bias[d][0] = b0.x; bias[d][1] = b0.y; bias[d][2] = b0.z; bias[d][3] = b0.w; bias[d][4] = b1.x; bias[d][5] = b1.y; bias[d][6] = b1.z; bias[d][7] = b1.w;
    }
    {
        const uint32_t aw[4] = {araw.x, araw.y, araw.z, araw.w};
#pragma unroll
        for (int e = 0; e < 4; ++e) { sA[t * 33 + c0 + 2 * e] = bflo(aw[e]); sA[t * 33 + c0 + 2 * e + 1] = bfhi(aw[e]); }
#pragma unroll
        for (int i = 0; i < 4; ++i) sWa[tid + 256 * i] = wreg[i];
#pragma unroll
        for (int i = 0; i < 2; ++i) { const int idx = tid + 256 * i, tt = idx >> 3, ch = idx & 7; *(u32x4*)(sV + tt * 64 + ch * 8) = vraw[i]; }
    }
    __syncthreads();
#pragma unroll
    for (int d = 0; d < 2; ++d) {
        float a8[8];
#pragma unroll
        for (int e = 0; e < 8; ++e) a8[e] = bias[d][e];
#pragma unroll
        for (int rr = 0; rr < 16; ++rr) {
            const float av = sA[t * 33 + d * 16 + rr];
            const float4 w0 = *(const float4*)(sWa + (d * 16 + rr) * 32 + c0), w1 = *(const float4*)(sWa + (d * 16 + rr) * 32 + c0 + 4);
            a8[0] += av * w0.x; a8[1] += av * w0.y; a8[2] += av * w0.z; a8[3] += av * w0.w; a8[4] += av * w1.x; a8[5] += av * w1.y; a8[6] += av * w1.z; a8[7] += av * w1.w;
        }
#pragma unroll
        for (int e = 0; e < 8; ++e) { const float xv = a8[e]; sG[(d * 64 + t) * 33 + c0 + e] = (fminf(xv, 0.f) - __logf(1.f + __expf(-fabsf(xv)))) * (1.f / 16.f); }
    }
    __syncthreads();
    {
        const int cc = tid & 63, d = cc >> 5, col = cc & 31, seg = tid >> 6;
        float v[16];
#pragma unroll
        for (int i = 0; i < 16; ++i) { const int tok = d ? (seg * 16 + 15 - i) : (seg * 16 + i); v[i] = sG[(d * 64 + tok) * 33 + col]; }
        float run = 0.f;
#pragma unroll
        for (int i = 0; i < 16; ++i) { run += v[i]; v[i] = run; }
        sSeg[seg * 64 + cc] = run;
        __syncthreads();
        float off = 0.f;
#pragma unroll
        for (int sg = 0; sg < 4; ++sg) { const float tv = sSeg[sg * 64 + cc]; off += (d ? (sg > seg) : (sg < seg)) ? tv : 0.f; }
#pragma unroll
        for (int i = 0; i < 16; ++i) { const int tok = d ? (seg * 16 + 15 - i) : (seg * 16 + i); sG[(d * 64 + tok) * 33 + col] = v[i] + off; }
        if (seg == (d ? 0 : 3)) {
            const float lastv = v[15] + off;
            sLast[d * 32 + col] = lastv;
            ((float*)(p.ws + OFF_LAST))[((size_t)((d * NB + b) * 68 + g) * 4 + h) * 32 + col] = lastv;
        }
    }
    __syncthreads();
    {
        float* CUM = (float*)(p.ws + OFF_CUM);
        const uint32_t kw[4] = {kraw.x, kraw.y, kraw.z, kraw.w};
#pragma unroll
        for (int d = 0; d < 2; ++d) {
            float cm[8];
#pragma unroll
            for (int e = 0; e < 8; ++e) cm[e] = sG[(d * 64 + t) * 33 + c0 + e];
            float* cp = CUM + ((size_t)d * TT + row0 + t) * 128 + h * 32 + c0;
            *(float4*)cp = make_float4(cm[0], cm[1], cm[2], cm[3]);
            *(float4*)(cp + 4) = make_float4(cm[4], cm[5], cm[6], cm[7]);
#pragma unroll
            for (int e = 0; e < 4; ++e) {
                sG[(d * 64 + t) * 33 + c0 + 2 * e] = bflo(kw[e]) * __expf(sLast[d * 32 + c0 + 2 * e] - cm[2 * e]);
                sG[(d * 64 + t) * 33 + c0 + 2 * e + 1] = bfhi(kw[e]) * __expf(sLast[d * 32 + c0 + 2 * e + 1] - cm[2 * e + 1]);
            }
        }
    }
    __syncthreads();
    {
        const int dk = tid >> 3, dv0 = (tid & 7) * 8;
        float af[8], ab[8];
#pragma unroll
        for (int e = 0; e < 8; ++e) { af[e] = 0.f; ab[e] = 0.f; }
#pragma unroll 8
        for (int tt = 0; tt < 64; ++tt) {
            const float kf = sG[tt * 33 + dk], kb = sG[(64 + tt) * 33 + dk];
            const u32x4 vv = *(const u32x4*)(sV + tt * 64 + dv0);
            const float v0 = bflo(vv.x), v1 = bfhi(vv.x), v2 = bflo(vv.y), v3 = bfhi(vv.y), v4 = bflo(vv.z), v5 = bfhi(vv.z), v6 = bflo(vv.w), v7 = bfhi(vv.w);
            af[0] += kf * v0; af[1] += kf * v1; af[2] += kf * v2; af[3] += kf * v3; af[4] += kf * v4; af[5] += kf * v5; af[6] += kf * v6; af[7] += kf * v7;
            ab[0] += kb * v0; ab[1] += kb * v1; ab[2] += kb * v2; ab[3] += kb * v3; ab[4] += kb * v4; ab[5] += kb * v5; ab[6] += kb * v6; ab[7] += kb * v7;
        }
        float* df = (float*)(p.ws + OFF_DS) + ((size_t)((0 * NB + b) * 68 + g) * 4 + h) * 2048 + dk * 64 + dv0;
        float* db = (float*)(p.ws + OFF_DS) + ((size_t)((1 * NB + b) * 68 + g) * 4 + h) * 2048 + dk * 64 + dv0;
        *(float4*)df = make_float4(af[0], af[1], af[2], af[3]); *(float4*)(df + 4) = make_float4(af[4], af[5], af[6], af[7]);
        *(float4*)db = make_float4(ab[0], ab[1], ab[2], ab[3]); *(float4*)(db + 4) = make_float4(ab[4], ab[5], ab[6], ab[7]);
    }
}

DI void gla_scan_item(const Params& p, int it) {
    const int tid = otid();
    const int part = it & 3, h = (it >> 2) & 3, b = (it >> 4) & 7, d = it >> 7;
    const float* DS = (const float*)(p.ws + OFF_DS);
    const float* LAST = (const float*)(p.ws + OFF_LAST);
    float* SP = (float*)(p.ws + OFF_SPREV);
    const int e0 = part * 512 + tid * 2, dk = e0 >> 6;
    const size_t base = (size_t)((d * NB + b) * 68) * 4 + h;
    float s0 = 0.f, s1 = 0.f;
#pragma unroll 17
    for (int st = 0; st < 68; ++st) {
        const int g = d == 0 ? st : (st < 4 ? 3 - st : 71 - st);
        const size_t ix = base + (size_t)g * 4;
        const float e = __expf(LAST[ix * 32 + dk]);
        const float2 dv = *(const float2*)(DS + ix * 2048 + e0);
        *(float2*)(SP + ix * 2048 + e0) = make_float2(s0, s1);
        s0 = s0 * e + dv.x; s1 = s1 * e + dv.y;
    }
}

DI void gla_out_item(const Params& p, int l, int b, int h, int g, char* smem) {
    const int tid = otid(), wave = tid >> 6, lane = tid & 63, r = lane & 31, hh = lane >> 5, qb = wave & 1, db = wave >> 1;
    const int row0 = chunk_row0(b, g);
    u16* U = (u16*)(p.ws + OFF_U);
    const float* CUM = (const float*)(p.ws + OFF_CUM);
    u16* sS = (u16*)smem;
    u16* sQ = sS + 64 * 40;
    u16* sK = sQ + 64 * 40;
    u16* sVt = sK + 64 * 40;
    float* sRed = (float*)(sVt + 64 * 72);
    const int dk = tid >> 3, dv0 = (tid & 7) * 8;
    float Sf[8], Sb[8];
    {
        const float* SP = (const float*)(p.ws + OFF_SPREV);
        const float* pf = SP + ((size_t)((0 * NB + b) * 68 + g) * 4 + h) * 2048 + dk * 64 + dv0;
        const float* pb = SP + ((size_t)((1 * NB + b) * 68 + g) * 4 + h) * 2048 + dk * 64 + dv0;
        const float4 a0 = *(const float4*)pf, a1 = *(const float4*)(pf + 4), b0 = *(const float4*)pb, b1 = *(const float4*)(pb + 4);
        Sf[0] = a0.x; Sf[1] = a0.y; Sf[2] = a0.z; Sf[3] = a0.w; Sf[4] = a1.x; Sf[5] = a1.y; Sf[6] = a1.z; Sf[7] = a1.w;
        Sb[0] = b0.x; Sb[1] = b0.y; Sb[2] = b0.z; Sb[3] = b0.w; Sb[4] = b1.x; Sb[5] = b1.y; Sb[6] = b1.z; Sb[7] = b1.w;
    }
    f32x16 o;
#pragma unroll
    for (int i = 0; i < 16; ++i) o[i] = 0.f;
    const int t_ = tid >> 2, c0_ = (tid & 3) * 8, d0_ = (tid & 3) * 16;
    const u32x4 v0 = *(const u32x4*)(U + (size_t)(row0 + t_) * NIN + C_LV + h * 64 + d0_), v1 = *(const u32x4*)(U + (size_t)(row0 + t_) * NIN + C_LV + h * 64 + d0_ + 8);
    const u32x4 qv = *(const u32x4*)(U + (size_t)(row0 + t_) * NIN + C_LQ + h * 32 + c0_), kv = *(const u32x4*)(U + (size_t)(row0 + t_) * NIN + C_LK + h * 32 + c0_);
    float4 cma[2], cmb[2];
#pragma unroll
    for (int d = 0; d < 2; ++d) { const float* cp = CUM + ((size_t)d * TT + row0 + t_) * 128 + h * 32 + c0_; cma[d] = *(const float4*)cp; cmb[d] = *(const float4*)(cp + 4); }
    __syncthreads();
    {
        const int t = t_, d0 = d0_;
        const uint32_t w[8] = {v0.x, v0.y, v0.z, v0.w, v1.x, v1.y, v1.z, v1.w};
#pragma unroll
        for (int e = 0; e < 8; ++e) { sVt[(d0 + 2 * e) * 72 + t] = (u16)(w[e] & 0xffffu); sVt[(d0 + 2 * e + 1) * 72 + t] = (u16)(w[e] >> 16); }
    }
#pragma unroll
    for (int d = 0; d < 2; ++d) {
        if (d) __syncthreads();
        {
#pragma unroll
            for (int e = 0; e < 8; ++e) sS[(dv0 + e) * 40 + dk] = f2bf(d ? Sb[e] : Sf[e]);
            const int t = t_, c0 = c0_;
            const float4 ca = cma[d], cb = cmb[d];
            const float cm[8] = {ca.x, ca.y, ca.z, ca.w, cb.x, cb.y, cb.z, cb.w};
            const uint32_t qw[4] = {qv.x, qv.y, qv.z, qv.w}, kw[4] = {kv.x, kv.y, kv.z, kv.w};
            u32x4 qo, ko;
#pragma unroll
            for (int e = 0; e < 4; ++e) {
                const float e0 = __expf(cm[2 * e]), e1 = __expf(cm[2 * e + 1]);
                qo[e] = pack2(bflo(qw[e]) * e0 * 0.17677669529663687f, bfhi(qw[e]) * e1 * 0.17677669529663687f);
                ko[e] = pack2(bflo(kw[e]) / e0, bfhi(kw[e]) / e1);
            }
            *(u32x4*)(sQ + t * 40 + c0) = qo;
            *(u32x4*)(sK + t * 40 + c0) = ko;
        }
        __syncthreads();
        bf16x8 qf[2];
#pragma unroll
        for (int ks = 0; ks < 2; ++ks) qf[ks] = *(const bf16x8*)(sQ + (qb * 32 + r) * 40 + ks * 16 + hh * 8);
        const int pr = (r & 0x13) | ((r & 4) << 1) | ((r & 8) >> 1);
#pragma unroll
        for (int kb = 0; kb < 2; ++kb) {
            if (d == 0 ? (kb > qb) : (kb < qb)) continue;
            f32x16 s;
#pragma unroll
            for (int i = 0; i < 16; ++i) s[i] = 0.f;
#pragma unroll
            for (int ks = 0; ks < 2; ++ks) s = MFMA(*(const bf16x8*)(sK + (kb * 32 + pr) * 40 + ks * 16 + hh * 8), qf[ks], s);
            const int iq = qb * 32 + r;
#pragma unroll
            for (int i = 0; i < 16; ++i) {
                const int jk = kb * 32 + 16 * (i >> 3) + 8 * hh + (i & 7);
                const bool keep = d == 0 ? (jk <= iq) : (jk >= iq);
                s[i] = keep ? s[i] : 0.f;
            }
#pragma unroll
            for (int sp = 0; sp < 2; ++sp) {
                u32x4 pk; pk.x = pack2(s[8 * sp], s[8 * sp + 1]); pk.y = pack2(s[8 * sp + 2], s[8 * sp + 3]); pk.z = pack2(s[8 * sp + 4], s[8 * sp + 5]); pk.w = pack2(s[8 * sp + 6], s[8 * sp + 7]);
                o = MFMA(*(const bf16x8*)(sVt + (db * 32 + r) * 72 + kb * 32 + 16 * sp + 8 * hh), __builtin_bit_cast(bf16x8, pk), o);
            }
        }
#pragma unroll
        for (int ks = 0; ks < 2; ++ks) o = MFMA(*(const bf16x8*)(sS + (db * 32 + r) * 40 + ks * 16 + hh * 8), qf[ks], o);
    }
    float ss = 0.f;
#pragma unroll
    for (int i = 0; i < 16; ++i) ss += o[i] * o[i];
    ss += __shfl_xor(ss, 32);
    if (hh == 0) sRed[db * 64 + qb * 32 + r] = ss;
    __syncthreads();
    const float rstd = rsqrtf((sRed[qb * 32 + r] + sRed[64 + qb * 32 + r]) * (1.f / 64.f) + EPS);
    u16* zp = U + (size_t)(row0 + qb * 32 + r) * NIN + C_Z + h * 64 + db * 32 + 4 * hh;
    const float* nw = p.gla_nw + l * 64 + db * 32 + 4 * hh;
#pragma unroll
    for (int g4 = 0; g4 < 4; ++g4) {
        const u32x2 zz = *(const u32x2*)(zp + 8 * g4);
        const float4 w4 = *(const float4*)(nw + 8 * g4);
        u32x2 y;
        y.x = pack2(o[4 * g4] * rstd * w4.x * silu(bflo(zz.x)), o[4 * g4 + 1] * rstd * w4.y * silu(bfhi(zz.x)));
        y.y = pack2(o[4 * g4 + 2] * rstd * w4.z * silu(bflo(zz.y)), o[4 * g4 + 3] * rstd * w4.w * silu(bfhi(zz.y)));
        *(u32x2*)(zp + 8 * g4) = y;
    }
}

template <int DQK>
DI void attn_item(const u16* __restrict__ Q, const u16* __restrict__ K, const u16* __restrict__ Vt, int nkeys, int q0, u16* yz  , char* smem) {
    constexpr int KST = DQK + 8, NKS = DQK / 16, CPR = DQK / 8, NKC = 64 * CPR / 256, STG = 64 * KST + 64 * 72;
    const int tid = otid(), wave = tid >> 6, lane = tid & 63, r = lane & 31, h = lane >> 5;
    u16* sbase = (u16*)smem;
    bf16x8 qf[NKS];
#pragma unroll
    for (int ks = 0; ks < NKS; ++ks) qf[ks] = *(const bf16x8*)(Q + (size_t)(q0 + wave * 32 + r) * DQK + ks * 16 + h * 8);
    f32x16 o[2];
#pragma unroll
    for (int i = 0; i < 16; ++i) { o[0][i] = 0.f; o[1][i] = 0.f; }
    float mref = 0.f, lsum = 0.f;
    f32x16 negm;
#pragma unroll
    for (int i = 0; i < 16; ++i) negm[i] = 0.f;
    u32x4 rk[NKC], rv[2];
    const int ntiles = nkeys >> 6;
#pragma unroll
    for (int i = 0; i < NKC; ++i) { const int c = tid + 256 * i, row = c / CPR, ch = c % CPR; rk[i] = *(const u32x4*)(K + (size_t)row * DQK + ch * 8); }
#pragma unroll
    for (int i = 0; i < 2; ++i) { const int c = tid + 256 * i, row = c >> 3, ch = c & 7; rv[i] = *(const u32x4*)(Vt + (size_t)row * TALL + ch * 8); }
#pragma unroll
    for (int i = 0; i < NKC; ++i) { const int c = tid + 256 * i, row = c / CPR, ch = c % CPR; *(u32x4*)(sbase + row * KST + ch * 8) = rk[i]; }
#pragma unroll
    for (int i = 0; i < 2; ++i) { const int c = tid + 256 * i, row = c >> 3, ch = c & 7; *(u32x4*)(sbase + 64 * KST + row * 72 + ch * 8) = rv[i]; }
#pragma unroll
    for (int i = 0; i < NKC; ++i) { const int c = tid + 256 * i, row = c / CPR, ch = c % CPR; rk[i] = *(const u32x4*)(K + (size_t)(64 + row) * DQK + ch * 8); }
#pragma unroll
    for (int i = 0; i < 2; ++i) { const int c = tid + 256 * i, row = c >> 3, ch = c & 7; rv[i] = *(const u32x4*)(Vt + (size_t)row * TALL + 64 + ch * 8); }
    __syncthreads();
    const int pr = (r & 0x13) | ((r & 4) << 1) | ((r & 8) >> 1);
    for (int kt = 0; kt < ntiles; ++kt) {
        const u16* sK = sbase + (kt & 1) * STG;
        const u16* sVt = sK + 64 * KST;
        f32x16 s[2];
        {
            bf16x8 kf0[NKS], kf1[NKS];
#pragma unroll
            for (int ks = 0; ks < NKS; ++ks) kf0[ks] = *(const bf16x8*)(sK + pr * KST + ks * 16 + h * 8);
            mfence();
#pragma unroll
            for (int ks = 0; ks < NKS; ++ks) kf1[ks] = *(const bf16x8*)(sK + (32 + pr) * KST + ks * 16 + h * 8);
            mfence();
            if (kt + 1 < ntiles) {
                u16* dK = sbase + ((kt + 1) & 1) * STG;
#pragma unroll
                for (int i = 0; i < NKC; ++i) { const int c = tid + 256 * i, row = c / CPR, ch = c % CPR; *(u32x4*)(dK + row * KST + ch * 8) = rk[i]; }
#pragma unroll
                for (int i = 0; i < 2; ++i) { const int c = tid + 256 * i, row = c >> 3, ch = c & 7; *(u32x4*)(dK + 64 * KST + row * 72 + ch * 8) = rv[i]; }
                if (kt + 2 < ntiles) {
                    const int key0 = (kt + 2) * 64;
#pragma unroll
                    for (int i = 0; i < NKC; ++i) { const int c = tid + 256 * i, row = c / CPR, ch = c % CPR; rk[i] = *(const u32x4*)(K + (size_t)(key0 + row) * DQK + ch * 8); }
#pragma unroll
                    for (int i = 0; i < 2; ++i) { const int c = tid + 256 * i, row = c >> 3, ch = c & 7; rv[i] = *(const u32x4*)(Vt + (size_t)row * TALL + key0 + ch * 8); }
                }
            }
            mfence();
            s[0] = MFMA(kf0[0], qf[0], negm);
            s[1] = MFMA(kf1[0], qf[0], negm);
#pragma unroll
            for (int ks = 1; ks < NKS; ++ks) { s[0] = MFMA(kf0[ks], qf[ks], s[0]); s[1] = MFMA(kf1[ks], qf[ks], s[1]); }
        }
        bf16x8 vf[2][4];
#pragma unroll
        for (int db = 0; db < 2; ++db)
#pragma unroll
            for (int q = 0; q < 4; ++q) vf[db][q] = *(const bf16x8*)(sVt + (db * 32 + r) * 72 + q * 16 + 8 * h);
        mfence();
        float mx = fmaxf(s[0][0], s[1][0]);
#pragma unroll
        for (int i = 1; i < 16; ++i) mx = max3f(mx, s[0][i], s[1][i]);
        mx = xhalf_max(mx);
        const bool need = (kt == 0) || (mx > 8.f);
        if (__builtin_amdgcn_ballot_w64(need) != 0ull) {
            const float delta = need ? mx : 0.f, alpha = __builtin_amdgcn_exp2f(-delta);
            mref += delta; lsum *= alpha;
#pragma unroll
            for (int i = 0; i < 16; ++i) { o[0][i] *= alpha; o[1][i] *= alpha; s[0][i] -= delta; s[1][i] -= delta; negm[i] = -mref; }
        }
        float ps = 0.f;
#pragma unroll
        for (int kb = 0; kb < 2; ++kb)
#pragma unroll
            for (int i = 0; i < 16; ++i) { const float pv = __builtin_amdgcn_exp2f(s[kb][i]); s[kb][i] = pv; ps += pv; }
        lsum += ps;
#pragma unroll
        for (int kb = 0; kb < 2; ++kb)
#pragma unroll
            for (int sp = 0; sp < 2; ++sp) {
                u32x4 pk; pk.x = pack2(s[kb][8 * sp], s[kb][8 * sp + 1]); pk.y = pack2(s[kb][8 * sp + 2], s[kb][8 * sp + 3]);
                pk.z = pack2(s[kb][8 * sp + 4], s[kb][8 * sp + 5]); pk.w = pack2(s[kb][8 * sp + 6], s[kb][8 * sp + 7]);
                const bf16x8 pb = __builtin_bit_cast(bf16x8, pk);
#pragma unroll
                for (int db = 0; db < 2; ++db) o[db] = MFMA(vf[db][kb * 2 + sp], pb, o[db]);
            }
        __syncthreads();
    }
    lsum = xhalf_sum(lsum);
    const float inv = 1.f / lsum;
    float* sF = (float*)smem;
#pragma unroll
    for (int db = 0; db < 2; ++db)
#pragma unroll
        for (int g4 = 0; g4 < 4; ++g4)
            *(float4*)(sF + (wave * 32 + r) * 68 + db * 32 + 8 * g4 + 4 * h) = make_float4(o[db][4 * g4] * inv, o[db][4 * g4 + 1] * inv, o[db][4 * g4 + 2] * inv, o[db][4 * g4 + 3] * inv);
    __syncthreads();
#pragma unroll
    for (int i = 0; i < 4; ++i) {
        const int idx = tid + 256 * i, row = idx >> 3, ch = idx & 7;
        u16* zq = yz + (size_t)row * NIN + ch * 8;
        const u32x4 zz = *(const u32x4*)zq;
        const float4 a = *(const float4*)(sF + row * 68 + ch * 8), b = *(const float4*)(sF + row * 68 + ch * 8 + 4);
        u32x4 y;
        y.x = pack2(a.x * silu(bflo(zz.x)), a.y * silu(bfhi(zz.x))); y.y = pack2(a.z * silu(bflo(zz.y)), a.w * silu(bfhi(zz.y)));
        y.z = pack2(b.x * silu(bflo(zz.z)), b.y * silu(bfhi(zz.z))); y.w = pack2(b.z * silu(bflo(zz.w)), b.w * silu(bfhi(zz.w)));
        *(u32x4*)zq = y;
    }
}

DI void attn_dispatch(const Params& p, int pair, int qt, int is_ctx, char* smem) {
    const int b = pair / 12, hd = pair % 12;
    const int q0 = is_ctx ? qt * 128 : 256 + qt * 128, nkeys = is_ctx ? 256 : TALL;
    const int row0 = is_ctx ? NLAT + b * 256 + qt * 128 : b * 4096 + qt * 128;
    u16* U = (u16*)(p.ws + OFF_U);
    if (hd < 6) {
        const size_t bh = (size_t)(b * 6 + hd);
        attn_item<96>((const u16*)(p.ws + OFF_QM) + bh * TALL * 96, (const u16*)(p.ws + OFF_KM) + bh * TALL * 96, (const u16*)(p.ws + OFF_VTM) + bh * 64 * TALL, nkeys, q0,
                      U + (size_t)row0 * NIN + C_Z + 256 + hd * 64, smem);
    } else {
        const int hq = hd - 6, kvh = hq / 3;
        attn_item<64>((const u16*)(p.ws + OFF_QG) + (size_t)(b * 6 + hq) * TALL * 64, (const u16*)(p.ws + OFF_KG) + (size_t)(b * 2 + kvh) * TALL * 64,
                      (const u16*)(p.ws + OFF_VTG) + (size_t)(b * 2 + kvh) * 64 * TALL, nkeys, q0, U + (size_t)row0 * NIN + C_Z + 640 + hq * 64, smem);
    }
}

DI void outproj_tile(const Params& p, int l, int mt, int nt, char* smem) {
    const int tid = otid(), wave = tid >> 6, lane = tid & 63, r = lane & 31, h = lane >> 5, wf = wave & 1, wt = wave >> 1;
    u16* sW = (u16*)smem;
    f32x16 acc[2][4]; zero_acc(acc);
    gemm_core((const u16*)(p.ws + OFF_WOUT) + ((size_t)l * 1024 + nt * 128) * 1024, 1024, (const u16*)(p.ws + OFF_U) + (size_t)mt * TM * NIN + C_Z, NIN, 1024, sW, acc);
    const int j = mt < 128 ? (mt >> 4) : 8;
    const float* MOD = (const float*)(p.ws + OFF_MOD);
    float* sF = (float*)smem;
    const int c4 = (tid & 31) * 4, n = nt * 128 + c4;
    const float4 gv = *(const float4*)(MOD + (size_t)(l * 9 + j) * 3072 + 2048 + n);
    float4 gn = make_float4(0.f, 0.f, 0.f, 0.f);
    if (l < DEPTH - 1) {
        const float4 sv = *(const float4*)(MOD + (size_t)((l + 1) * 9 + j) * 3072 + 1024 + n), wv = *(const float4*)(p.norm_w + (l + 1) * 1024 + n);
        gn = make_float4(wv.x * (1.f + sv.x), wv.y * (1.f + sv.y), wv.z * (1.f + sv.z), wv.w * (1.f + sv.w));
    }
#pragma unroll
    for (int half = 0; half < 2; ++half) {
        __syncthreads();
        if (wt == half) {
#pragma unroll
            for (int tb = 0; tb < 4; ++tb)
#pragma unroll
                for (int fb = 0; fb < 2; ++fb)
#pragma unroll
                    for (int g4 = 0; g4 < 4; ++g4)
                        *(float4*)(sF + (tb * 32 + r) * 132 + wf * 64 + fb * 32 + 8 * g4 + 4 * h) =
                            make_float4(acc[fb][tb][4 * g4], acc[fb][tb][4 * g4 + 1], acc[fb][tb][4 * g4 + 2], acc[fb][tb][4 * g4 + 3]);
        }
        __syncthreads();
        float4 xin[16];
#pragma unroll
        for (int i = 0; i < 16; ++i) {
            const int row = mt * TM + half * 128 + (tid >> 5) + 8 * i;
            const bool lat = row < NLAT;
            const float* xo = l == 0 ? (lat ? p.x + (size_t)row * 1024 : p.ctx + (size_t)(row - NLAT) * 1024)
                                     : (lat ? p.out + (size_t)row * 1024 : (const float*)(p.ws + OFF_CTXX) + (size_t)(row - NLAT) * 1024);
            xin[i] = *(const float4*)(xo + n);
        }
#pragma unroll
        for (int i = 0; i < 16; ++i) {
            const int rr = (tid >> 5) + 8 * i, row = mt * TM + half * 128 + rr;
            const bool lat = row < NLAT;
            float* xn = lat ? p.out + (size_t)row * 1024 : (float*)(p.ws + OFF_CTXX) + (size_t)(row - NLAT) * 1024;
            const float4 xv = xin[i], av = *(const float4*)(sF + rr * 132 + c4);
            float4 nv;
            nv.x = xv.x + gv.x * av.x; nv.y = xv.y + gv.y * av.y; nv.z = xv.z + gv.z * av.z; nv.w = xv.w + gv.w * av.w;
            *(float4*)(xn + n) = nv;
            if (l < DEPTH - 1) {
                u32x2 o; o.x = pack2(nv.x * gn.x, nv.y * gn.y); o.y = pack2(nv.z * gn.z, nv.w * gn.w);
                *(u32x2*)((u16*)(p.ws + OFF_XG) + (size_t)row * 1024 + n) = o;
            }
            float ss = nv.x * nv.x + nv.y * nv.y + nv.z * nv.z + nv.w * nv.w;
            ss += __shfl_xor(ss, 1); ss += __shfl_xor(ss, 2); ss += __shfl_xor(ss, 4); ss += __shfl_xor(ss, 8); ss += __shfl_xor(ss, 16);
            if ((tid & 31) < 2) ((float*)(p.ws + OFF_RSS))[(size_t)row * 16 + nt * 2 + (tid & 31)] = (tid & 31) == 0 ? ss : 0.f;
        }
    }
}

DI void final_phase(const Params& p) {
    const int tid = otid(), wave = tid >> 6, lane = tid & 63;
    const float* RSS = (const float*)(p.ws + OFF_RSS);
    float4 w[4];
#pragma unroll
    for (int i = 0; i < 4; ++i) w[i] = *(const float4*)(p.final_nw + lane * 4 + 256 * i);
    for (int it = blockIdx.x; it < NLAT / 32; it += gridDim.x) {
        for (int rr = 0; rr < 8; ++rr) {
            const int row = it * 32 + wave * 8 + rr;
            float s = 0.f;
#pragma unroll
            for (int q = 0; q < 4; ++q) { const float4 v = *(const float4*)(RSS + (size_t)row * 16 + 4 * q); s += (v.x + v.y) + (v.z + v.w); }
            const float rstd = rsqrtf(s * (1.f / 1024.f) + EPS);
#pragma unroll
            for (int i = 0; i < 4; ++i) {
                float4* ptr = (float4*)(p.out + (size_t)row * 1024 + lane * 4 + 256 * i);
                float4 v = *ptr;
                v.x = v.x * rstd * w[i].x; v.y = v.y * rstd * w[i].y; v.z = v.z * rstd * w[i].z; v.w = v.w * rstd * w[i].w;
                *ptr = v;
            }
        }
    }
}


#define XB_TMO      128
#define XB_XCNT(j)  (256  + 64 * (j))
#define XB_XSUB(j)  (1280 + 64 * (j))
#define XB_XGEN(j)  (2304 + 64 * (j))
#define XB_TOP      3328
#define XB_TOPGEN   3392
#define XB_SPIN_CAP (1u << 22)
#define LAS __attribute__((address_space(3)))
DI unsigned xb_ld(unsigned* p) { return __hip_atomic_load(p, __ATOMIC_RELAXED, __HIP_MEMORY_SCOPE_AGENT); }
DI unsigned xb_add(unsigned* p, unsigned v) { return __hip_atomic_fetch_add(p, v, __ATOMIC_RELAXED, __HIP_MEMORY_SCOPE_AGENT); }
DI unsigned xb_xcc_id() { return (unsigned)__builtin_amdgcn_s_getreg((3 << 11) | 20) & 0xFu; }
#define XB_SPIN(cond, bar) do { unsigned _sp = 0; while (cond) { __builtin_amdgcn_s_sleep(0); \
    if ((++_sp & 255u) == 0u) { if (xb_ld(&(bar)[XB_TMO])) break; if (_sp > XB_SPIN_CAP) { atomicAdd(&(bar)[XB_TMO], 1u); break; } } } } while (0)
struct XcdBarrier { unsigned* bar; unsigned x; volatile LAS unsigned* st; };
DI XcdBarrier xcd_barrier_post(unsigned* bar, volatile LAS unsigned* st) {
    XcdBarrier b; b.bar = bar; b.x = xb_xcc_id(); b.st = st;
    if (threadIdx.x == 0) (void)xb_add(&bar[XB_XCNT(b.x)], 1u);
    return b;
}
DI void xcd_barrier_complete(unsigned* bar, unsigned x, unsigned& nloc, unsigned& nx) {
    const unsigned G = gridDim.x * gridDim.y * gridDim.z;
    unsigned sum, cnt, mine, sp = 0u;
    for (;;) {
        sum = 0u; cnt = 0u; mine = 0u;
#pragma unroll
        for (unsigned j = 0; j < 16; ++j) { const unsigned c = xb_ld(&bar[XB_XCNT(j)]); sum += c; cnt += (c > 0u) ? 1u : 0u; mine = (j == x) ? c : mine; }
        if (sum == G) break;
        __builtin_amdgcn_s_sleep(1);
        if ((++sp & 255u) == 0u) { if (xb_ld(&bar[XB_TMO])) break; if (sp > XB_SPIN_CAP) { atomicAdd(&bar[XB_TMO], 1u); break; } }
    }
    nloc = mine > 0u ? mine : 1u; nx = cnt > 0u ? cnt : 1u;
}
DI void xcd_barrier(const XcdBarrier& b) {
    asm volatile("s_waitcnt vmcnt(0)" ::: "memory");
    __syncthreads();
    if (threadIdx.x == 0) {
        unsigned* bar = b.bar;
        __builtin_amdgcn_s_waitcnt(0);
        unsigned nloc = b.st[0], nx = b.st[1];
        if (nloc == 0u) { xcd_barrier_complete(bar, b.x, nloc, nx); b.st[0] = nloc; b.st[1] = nx; }
        const unsigned old = xb_add(&bar[XB_XSUB(b.x)], 1u);
        const unsigned gen = old / nloc;
        if (old + 1u == (gen + 1u) * nloc) {
            __builtin_amdgcn_fence(__ATOMIC_RELEASE, "agent");
            asm volatile("s_waitcnt vmcnt(0)" ::: "memory");
            const unsigned og = xb_add(&bar[XB_TOP], 1u);
            const unsigned tg = og / nx;
            if (og + 1u == (tg + 1u) * nx) xb_add(&bar[XB_TOPGEN], 1u);
            else XB_SPIN(xb_ld(&bar[XB_TOPGEN]) == tg, bar);
            __builtin_amdgcn_fence(__ATOMIC_ACQUIRE, "agent");
            xb_add(&bar[XB_XGEN(b.x)], 1u);
            asm volatile("s_waitcnt vmcnt(0)" ::: "memory");
        } else {
            XB_SPIN(xb_ld(&bar[XB_XGEN(b.x)]) == gen, bar);
            __builtin_amdgcn_fence(__ATOMIC_ACQUIRE, "agent");
            asm volatile("s_waitcnt vmcnt(0)" ::: "memory");
        }
    }
    __syncthreads();
}


DI int fetch_item(unsigned* ctr, int* s_slot) {
    __syncthreads();
    if (threadIdx.x == 0) *s_slot = (int)__hip_atomic_fetch_add(ctr, 1u, __ATOMIC_RELAXED, __HIP_MEMORY_SCOPE_AGENT);
    __syncthreads();
    return *s_slot;
}
DI void run_phase(const Params& p, int ph, char* smem, int* s_slot) {
    unsigned* ctr = (unsigned*)(p.ws + OFF_BAR) + 3456 + 64 * ph;
    if (ph == 0) { phase0(p, smem); return; }
    if (ph == 1) { phase1(p, smem); return; }
    if (ph == NPHASE - 1) { final_phase(p); return; }
    const int l = (ph - 2) / 5, sub = (ph - 2) % 5;
    const bool want_ctx = l < DEPTH - 1;
    if (sub == 0) {
        const int xcd = blockIdx.x & 7, nbx = gridDim.x >> 3;
        for (int q = blockIdx.x >> 3; q < 17 * 22; q += nbx) {
            int mtl, nt;
            if (q < 352) { const int g = q / 176, rr = q % 176; if (rr < 128) { nt = (rr >> 6) * 8 + (rr & 7); mtl = g * 8 + ((rr & 63) >> 3); } else { const int r48 = rr - 128; nt = 16 + r48 % 6; mtl = g * 8 + r48 / 6; } }
            else { nt = q - 352; mtl = 16; }
            inproj_tile(p, l, xcd * 17 + mtl, nt, smem);
        }
    } else if (sub == 1) {
        constexpr int N_UP = 136 * 11, N_GL = NB * 68 * 4, N_TP = TT / 32;
        const int xcd = blockIdx.x & 7, nbx = gridDim.x >> 3;
        for (int q = blockIdx.x >> 3; q < 17 * 11; q += nbx) upproj_tile(p, l, xcd * 17 + q / 11, q % 11, smem);
        for (;;) {
            const int it = fetch_item(ctr, s_slot);
            if (it >= N_GL + N_TP) break;
            if (it < N_GL) gla_local_item(p, l, it, smem);
            else tokpost_item(p, l, it - N_GL, smem);
        }
    } else if (sub == 2) {
        for (int it = blockIdx.x; it < 256; it += gridDim.x) gla_scan_item(p, it);
    } else if (sub == 3) {
        const int n_lat = 3072, n_ctx = want_ctx ? 192 : 0, ng = want_ctx ? 68 : 64, n_gla = NB * 4 * ng;
        for (int it = blockIdx.x; it < n_lat; it += gridDim.x) {
            __syncthreads();
            const int pair = (it >> 8) * 8 + (it & 7), qt = (it >> 3) & 31;
            attn_dispatch(p, pair, qt, 0, smem);
        }
        for (;;) {
            const int it = fetch_item(ctr, s_slot);
            if (it >= n_ctx + n_gla) break;
            if (it < n_ctx) attn_dispatch(p, it >> 1, it & 1, 1, smem);
            else {
                const int i3 = it - n_ctx;
                const int g = (i3 % ng) + (want_ctx ? 0 : 4), h = (i3 / ng) & 3, b = i3 / (ng * 4);
                gla_out_item(p, l, b, h, g, smem);
            }
        }
    } else {
        const int mpx = want_ctx ? 17 : 16, xcd = blockIdx.x & 7, nbx = gridDim.x >> 3;
        for (int q = blockIdx.x >> 3; q < mpx * 8; q += nbx) outproj_tile(p, l, xcd * mpx + (q >> 3), q & 7, smem);
        if (l + 1 < DEPTH) for (;;) {
            const int it = fetch_item(ctr, s_slot);
            if (it >= 44 + N_WCONV) break;
            if (it < 44) bias_item(p, l + 1, it, smem);
            else wconv_item(p, l + 1, it - 44, (float*)smem);
        }
    }
}

__global__ void __launch_bounds__(256, 2) mega_kernel(Params p) {
    __shared__ __attribute__((aligned(16))) char smem[73728];
    __shared__ u32x4 xb_words;
    __shared__ int s_slot;
    if (p.phase_end < 0) cg::this_grid().sync();
    if (threadIdx.x == 0) xb_words = (u32x4){0u, 0u, 0u, 0u};
    __syncthreads();
    const XcdBarrier xb = xcd_barrier_post((unsigned*)(p.ws + OFF_BAR), (volatile LAS unsigned*)&xb_words);
    for (int ph = p.phase_begin; ph < p.phase_end; ++ph) {
        run_phase(p, ph, smem, &s_slot);
        if (ph + 1 < p.phase_end) xcd_barrier(xb);
    }
}

extern "C" void kernel_launch(void* const* d_in, const int* in_sizes, int n_in, void* d_out, int out_size, void* d_ws, size_t ws_size, hipStream_t stream) {
    (void)in_sizes; (void)n_in; (void)out_size;
    if (ws_size < WS_TOTAL) { fprintf(stderr, "workspace too small: %zu < %zu\n", ws_size, (size_t)WS_TOTAL); return; }
    Params p{};
    p.x = (const float*)d_in[0]; p.c = (const float*)d_in[1]; p.ctx = (const float*)d_in[2]; p.c_ctx = (const float*)d_in[3]; p.norm_w = (const float*)d_in[4];
    p.w_mod = (const float*)d_in[5]; p.b_mod = (const float*)d_in[6]; p.w_in = (const float*)d_in[7]; p.wa_f = (const float*)d_in[8]; p.ba_f = (const float*)d_in[9];
    p.wa_b = (const float*)d_in[10]; p.ba_b = (const float*)d_in[11]; p.gla_nw = (const float*)d_in[12]; p.mla_qnw = (const float*)d_in[13]; p.w_uq = (const float*)d_in[14];
    p.mla_kvnw = (const float*)d_in[15]; p.w_ukv = (const float*)d_in[16]; p.gqa_qnw = (const float*)d_in[17]; p.gqa_knw = (const float*)d_in[18]; p.w_out = (const float*)d_in[19];
    p.final_nw = (const float*)d_in[20];
    p.out = (float*)d_out; p.ws = (char*)d_ws;
    static int grid_blocks = 0;
    if (!grid_blocks) {
        int dev = 0, cus = 0, per_cu = 0;
        hipGetDevice(&dev);
        hipDeviceGetAttribute(&cus, hipDeviceAttributeMultiprocessorCount, dev);
        hipOccupancyMaxActiveBlocksPerMultiprocessor(&per_cu, mega_kernel, 256, 0);
        if (per_cu < 1) per_cu = 1;
        if (per_cu > 2) per_cu = 2;
        grid_blocks = (cus * per_cu) & ~7;
    }
#if MK_MODE == 1
    p.phase_begin = 0; p.phase_end = NPHASE;
    hipMemsetAsync((char*)d_ws + OFF_BAR, 0, SZ_BAR, stream);
    void* args[] = {&p};
    hipError_t e = hipLaunchCooperativeKernel((void*)mega_kernel, dim3(grid_blocks), dim3(256), args, 0, stream);
    if (e != hipSuccess) fprintf(stderr, "cooperative launch failed: %s (grid %d)\n", hipGetErrorString(e), grid_blocks);
#else
    for (int ph = 0; ph < NPHASE; ++ph) {
        p.phase_begin = ph; p.phase_end = ph + 1;
        hipLaunchKernelGGL(mega_kernel, dim3(grid_blocks), dim3(256), 0, stream, p);
    }
#endif
}
```
